# Optimizing an MI355X kernel written in HIP

```python
import jax, jax.numpy as jnp
from jax import lax
import numpy as np

D_MODEL = 1024
BATCH = 16
SEQ = 2048
DEPTH = 4

N_MIXERS = 3
PL_DIM = 256
EPS = 1e-6
BLOCK = 128

SB_HEADS = 16
SB_HEAD_DIM = D_MODEL // SB_HEADS
RET_HEADS = 4
RET_QK_DIM = D_MODEL // RET_HEADS
RET_V_DIM = 2 * D_MODEL // RET_HEADS
ROPE_BASE = 10000.0
SGU_WIDTH = 2 * D_MODEL
SGU_GROUPS = 8
SGU_GROUP_DIM = SGU_WIDTH // SGU_GROUPS
FFN_DIM = 2816
CONV_WIDTH = 3

N_SB = len(range(0, DEPTH, N_MIXERS))
N_RET = len(range(1, DEPTH, N_MIXERS))
N_SGU = len(range(2, DEPTH, N_MIXERS))

kernel_name = "hybrid_stickbreak_retention_sgu_trunk"


def rmsnorm(x, g):
    xf = x.astype(jnp.float32)
    y = xf * lax.rsqrt(jnp.mean(xf * xf, axis=-1, keepdims=True) + EPS)
    return (y * g.astype(jnp.float32)).astype(x.dtype)


def stick_breaking_attention(h, w_in, w_out):
    b, s, _ = h.shape
    qkv = h @ w_in
    q, k, v = jnp.split(qkv, 3, axis=-1)
    to_heads = lambda a: a.reshape(b, s, SB_HEADS, SB_HEAD_DIM).transpose(0, 2, 1, 3)
    q, k, v = to_heads(q), to_heads(k), to_heads(v)
    scale = SB_HEAD_DIM ** -0.5
    outs = []
    for blk in range(s // BLOCK):
        t0 = blk * BLOCK
        end = t0 + BLOCK
        qb = q[:, :, t0:end]
        kb = k[:, :, :end]
        vb = v[:, :, :end]
        z = jnp.einsum("bhtd,bhsd->bhts", qb, kb).astype(jnp.float32) * scale
        t_idx = t0 + jnp.arange(BLOCK)[:, None]
        s_idx = jnp.arange(end)[None, :]
        mask = s_idx < t_idx
        log_keep = jnp.where(mask, jax.nn.log_sigmoid(-z), 0.0)
        tail = lax.cumsum(log_keep, axis=3, reverse=True)
        between = jnp.concatenate([tail[..., 1:], jnp.zeros_like(tail[..., :1])], axis=-1)
        a = jnp.where(mask, jnp.exp(jax.nn.log_sigmoid(z) + between), 0.0)
        outs.append(jnp.einsum("bhts,bhsd->bhtd", a.astype(vb.dtype), vb))
    o = jnp.concatenate(outs, axis=2).transpose(0, 2, 1, 3).reshape(b, s, D_MODEL)
    return o @ w_out


def rotary(x, pos):
    half = x.shape[-1] // 2
    inv_freq = 1.0 / (ROPE_BASE ** (jnp.arange(half, dtype=jnp.float32) / half))
    ang = pos[:, None] * inv_freq[None, :]
    cos = jnp.cos(ang).astype(x.dtype)
    sin = jnp.sin(ang).astype(x.dtype)
    x1, x2 = x[..., :half], x[..., half:]
    return jnp.concatenate([x1 * cos - x2 * sin, x2 * cos + x1 * sin], axis=-1)


def retention(h, w_in, w_out):
    b, s, _ = h.shape
    nc = s // BLOCK
    proj = h @ w_in
    q = proj[..., :D_MODEL].reshape(b, s, RET_HEADS, RET_QK_DIM).transpose(0, 2, 1, 3)
    k = proj[..., D_MODEL:2 * D_MODEL].reshape(b, s, RET_HEADS, RET_QK_DIM).transpose(0, 2, 1, 3)
    v = proj[..., 2 * D_MODEL:4 * D_MODEL].reshape(b, s, RET_HEADS, RET_V_DIM).transpose(0, 2, 1, 3)
    g = proj[..., 4 * D_MODEL:]
    pos = jnp.arange(s, dtype=jnp.float32)
    q = rotary(q, pos)
    k = rotary(k, pos) * (RET_QK_DIM ** -0.5)
    q = q.reshape(b, RET_HEADS, nc, BLOCK, RET_QK_DIM)
    k = k.reshape(b, RET_HEADS, nc, BLOCK, RET_QK_DIM)
    v = v.reshape(b, RET_HEADS, nc, BLOCK, RET_V_DIM)

    log_gamma = jnp.log1p(-jnp.exp2(-5.0 - jnp.arange(RET_HEADS, dtype=jnp.float32)))
    idx = jnp.arange(BLOCK, dtype=jnp.float32)
    rel = idx[:, None] - idx[None, :]
    decay_intra = jnp.where(rel >= 0, jnp.exp(log_gamma[:, None, None] * jnp.maximum(rel, 0.0)), 0.0)
    decay_q = jnp.exp(log_gamma[:, None] * (idx + 1.0))
    decay_k = jnp.exp(log_gamma[:, None] * (BLOCK - 1.0 - idx))
    decay_chunk = jnp.exp(log_gamma * BLOCK)

    scores = jnp.einsum("bhncd,bhnmd->bhncm", q, k).astype(jnp.float32) * decay_intra[None, :, None]
    intra = jnp.einsum("bhncm,bhnme->bhnce", scores.astype(v.dtype), v)

    k_dec = k * decay_k[None, :, None, :, None].astype(k.dtype)

    def step(state, xs):
        qc, kc, vc = xs
        inter = jnp.einsum("bhcd,bhde->bhce", qc, state)
        state = state * decay_chunk[None, :, None, None] + jnp.einsum("bhcd,bhce->bhde", kc, vc).astype(jnp.float32)
        return state, inter.astype(jnp.float32)

    state0 = jnp.zeros((b, RET_HEADS, RET_QK_DIM, RET_V_DIM), jnp.float32)
    _, inter = lax.scan(step, state0, (jnp.moveaxis(q, 2, 0), jnp.moveaxis(k_dec, 2, 0), jnp.moveaxis(v, 2, 0)))
    inter = jnp.moveaxis(inter, 0, 2) * decay_q[None, :, None, :, None]
    o = intra.astype(jnp.float32) + inter

    mu = jnp.mean(o, axis=-1, keepdims=True)
    var = jnp.mean(jnp.square(o - mu), axis=-1, keepdims=True)
    o = (o - mu) * lax.rsqrt(var + EPS)
    o = o.transpose(0, 2, 3, 1, 4).reshape(b, s, RET_HEADS * RET_V_DIM)
    y = (jax.nn.silu(g.astype(jnp.float32)) * o).astype(h.dtype)
    return y @ w_out


def chunked_sgu(h, w_in, sgu_norm, w_s, b_s, w_out):
    b, s, _ = h.shape
    nc = s // BLOCK
    z = jax.nn.gelu(h @ w_in)
    u, v = jnp.split(z, 2, axis=-1)
    v = rmsnorm(v, sgu_norm).reshape(b, nc, BLOCK, SGU_GROUPS, SGU_GROUP_DIM)
    causal = jnp.tril(jnp.ones((BLOCK, BLOCK), dtype=w_s.dtype))
    w = w_s * causal[None]
    mixed = jnp.einsum("gts,bnsgc->bntgc", w, v) + b_s.T[None, None, :, :, None]
    return (u * mixed.reshape(b, s, SGU_WIDTH)) @ w_out


def conv_gated_ffn(h, w_in, conv_w, conv_b, w_out):
    s = h.shape[1]
    a = h @ w_in
    gate, up = a[..., :FFN_DIM], a[..., FFN_DIM:]
    gpad = jnp.pad(gate, ((0, 0), (CONV_WIDTH - 1, 0), (0, 0)))
    conv = conv_b + sum(gpad[:, tap:tap + s] * conv_w[tap] for tap in range(CONV_WIDTH))
    return (jax.nn.silu(conv) * up) @ w_out


def per_layer_embed(x, p_i, norm_g, w_gate, w_proj):
    gate = jax.nn.sigmoid((rmsnorm(x, norm_g) @ w_gate).astype(jnp.float32)).astype(x.dtype)
    return x + gate * (p_i @ w_proj)


def setup_inputs(seed: int = 0) -> dict:
    key = jax.random.key(seed)
    ks = iter(jax.random.split(key, 32))
    nrm = lambda shape, fan: jax.random.normal(next(ks), shape, jnp.float32) * (fan ** -0.5)
    gain = lambda shape: 1.0 + 0.02 * jax.random.normal(next(ks), shape, jnp.float32)
    return {
        "x": jax.random.normal(next(ks), (BATCH, SEQ, D_MODEL), jnp.float32),
        "p": jax.random.normal(next(ks), (DEPTH, BATCH, SEQ, PL_DIM), jnp.float32),
        "norm_mix": gain((DEPTH, D_MODEL)),
        "norm_ffn": gain((DEPTH, D_MODEL)),
        "norm_pl": gain((DEPTH, D_MODEL)),
        "norm_final": gain((D_MODEL,)),
        "sb_w_in": nrm((N_SB, D_MODEL, 3 * D_MODEL), D_MODEL),
        "sb_w_out": nrm((N_SB, D_MODEL, D_MODEL), D_MODEL),
        "ret_w_in": nrm((N_RET, D_MODEL, 6 * D_MODEL), D_MODEL),
        "ret_w_out": nrm((N_RET, 2 * D_MODEL, D_MODEL), 2 * D_MODEL),
        "sgu_w_in": nrm((N_SGU, D_MODEL, 2 * SGU_WIDTH), D_MODEL),
        "sgu_norm": gain((N_SGU, SGU_WIDTH)),
        "sgu_w_s": nrm((N_SGU, SGU_GROUPS, BLOCK, BLOCK), BLOCK),
        "sgu_b_s": gain((N_SGU, SGU_GROUPS, BLOCK)),
        "sgu_w_out": nrm((N_SGU, SGU_WIDTH, D_MODEL), SGU_WIDTH),
        "ffn_w_in": nrm((DEPTH, D_MODEL, 2 * FFN_DIM), D_MODEL),
        "ffn_conv_w": nrm((DEPTH, CONV_WIDTH, FFN_DIM), CONV_WIDTH),
        "ffn_conv_b": 0.02 * jax.random.normal(next(ks), (DEPTH, FFN_DIM), jnp.float32),
        "ffn_w_out": nrm((DEPTH, FFN_DIM, D_MODEL), FFN_DIM),
        "pl_w_gate": nrm((DEPTH, D_MODEL, D_MODEL), D_MODEL),
        "pl_w_proj": nrm((DEPTH, PL_DIM, D_MODEL), PL_DIM),
    }


def reference(x, p, norm_mix, norm_ffn, norm_pl, norm_final, sb_w_in, sb_w_out, ret_w_in, ret_w_out,
              sgu_w_in, sgu_norm, sgu_w_s, sgu_b_s, sgu_w_out, ffn_w_in, ffn_conv_w, ffn_conv_b, ffn_w_out,
              pl_w_gate, pl_w_proj):
    for i in range(DEPTH):
        kind = i % N_MIXERS
        j = i // N_MIXERS
        h = rmsnorm(x, norm_mix[i])
        if kind == 0:
            m = stick_breaking_attention(h, sb_w_in[j], sb_w_out[j])
        elif kind == 1:
            m = retention(h, ret_w_in[j], ret_w_out[j])
        else:
            m = chunked_sgu(h, sgu_w_in[j], sgu_norm[j], sgu_w_s[j], sgu_b_s[j], sgu_w_out[j])
        x = x + m
        x = x + conv_gated_ffn(rmsnorm(x, norm_ffn[i]), ffn_w_in[i], ffn_conv_w[i], ffn_conv_b[i], ffn_w_out[i])
        x = per_layer_embed(x, p[i], norm_pl[i], pl_w_gate[i], pl_w_proj[i])
    return rmsnorm(x, norm_final)
```

```cpp
#include <hip/hip_runtime.h>
#include <hip/hip_cooperative_groups.h>
#include <cstdio>
#include <cstdint>
namespace cg = cooperative_groups;

#define LAS __attribute__((address_space(3)))
#define GAS __attribute__((address_space(1)))
typedef unsigned short bf16_t;
typedef short bf16x8 __attribute__((ext_vector_type(8)));
typedef short s16x4 __attribute__((ext_vector_type(4)));
typedef float f32x4 __attribute__((ext_vector_type(4)));
typedef float f32x2 __attribute__((ext_vector_type(2)));
typedef float f32x16 __attribute__((ext_vector_type(16)));
typedef unsigned u32x4 __attribute__((ext_vector_type(4)));
typedef unsigned u32x2 __attribute__((ext_vector_type(2)));

constexpr int D = 1024, SEQ = 2048, DEPTH = 4, FFN = 2816, PLD = 256;
constexpr int TH = 16384;
constexpr int TFULL = 32768;
constexpr float EPS = 1e-6f;
constexpr float LOG2E = 1.4426950408889634f;

constexpr size_t W_SB_IN = 0, W_SB_OUT = 6291456, W_RET_IN = 8388608, W_RET_OUT = 14680064, W_SGU_IN = 16777216, W_SGU_OUT = 20971520,
                 W_FFN_IN = 23068672, W_FFN_OUT = 46137344, W_PL_GATE = 57671680, W_PL_PROJ = 61865984, W_END = 62914560;
constexpr size_t MiB = 1u << 20;
constexpr size_t OFF_COS = 1 * MiB, OFF_SIN = 2 * MiB, OFF_W = 3 * MiB, OFF_XB = 123 * MiB, OFF_PB = 155 * MiB, OFF_PP = 163 * MiB,
                 OFF_SSP0 = 195 * MiB, OFF_SSP1 = 196 * MiB, OFF_SSV = 197 * MiB, OFF_RST = 199 * MiB, OFF_BIG1 = 207 * MiB, OFF_BIG2 = 399 * MiB, OFF_QF = 463 * MiB  , WS_NEED = 495 * MiB;
constexpr int LDS_BYTES = 135168;
constexpr int LDS_RSL = 131072 + 512;

struct MatDesc { const float* W; const float* gain; bf16_t* dst; int K, N, perm, pad; };
struct Params {
    const float* x; const float* p; const float* norm_final; const float* sgu_norm; const float* sgu_w_s; const float* sgu_b_s;
    const float* conv_w; const float* conv_b; float* out; unsigned char* ws;
    MatDesc mats[24];
};

#define LDS_BARRIER() do { asm volatile("s_waitcnt lgkmcnt(0)" ::: "memory"); __builtin_amdgcn_s_barrier(); asm volatile("" ::: "memory"); } while (0)
__device__ __forceinline__ int opq_tid() { int t = threadIdx.x; asm volatile("" : "+v"(t)); return t; }
template <class T> __device__ __forceinline__ T* opq_ptr(T* p) { asm volatile("" : "+s"(p)); return p; }
__device__ __forceinline__ int opq_s(int v) { asm volatile("" : "+s"(v)); return v; }
__device__ __forceinline__ unsigned cvt_pk_bf16(float lo, float hi) { unsigned r; asm volatile("v_cvt_pk_bf16_f32 %0, %1, %2" : "=v"(r) : "v"(lo), "v"(hi)); return r; }
__device__ __forceinline__ float bf_lo(unsigned w) { return __uint_as_float(w << 16); }
__device__ __forceinline__ float bf_hi(unsigned w) { return __uint_as_float(w & 0xffff0000u); }
__device__ __forceinline__ float wave_sum(float v) {
#pragma unroll
    for (int o = 1; o < 64; o <<= 1) v += __shfl_xor(v, o);
    return v;
}
__device__ __forceinline__ float fast_sigmoid(float g) { return __builtin_amdgcn_rcpf(1.f + __builtin_amdgcn_exp2f(-g * LOG2E)); }
__device__ __forceinline__ float gelu_tanh(float x) { const float u = 0.7978845608028654f * (x + 0.044715f * x * x * x); return x * fast_sigmoid(2.f * u); }
__device__ __forceinline__ f32x16 mfma32(bf16x8 a, bf16x8 b, f32x16 c) { return __builtin_amdgcn_mfma_f32_32x32x16_bf16(a, b, c, 0, 0, 0); }
__device__ __forceinline__ s16x4 tr_read(LAS unsigned char* p) {
    typedef short v4i16_t __attribute__((ext_vector_type(4)));
    return __builtin_bit_cast(s16x4, __builtin_amdgcn_ds_read_tr16_b64_v4i16((LAS v4i16_t*)p));
}
__device__ __forceinline__ bf16x8 cat4(s16x4 lo, s16x4 hi) { bf16x8 r; r[0] = lo[0]; r[1] = lo[1]; r[2] = lo[2]; r[3] = lo[3]; r[4] = hi[0]; r[5] = hi[1]; r[6] = hi[2]; r[7] = hi[3]; return r; }
__device__ __forceinline__ bf16x8 pack8(float a0, float a1, float a2, float a3, float a4, float a5, float a6, float a7) {
    u32x4 w; w.x = cvt_pk_bf16(a0, a1); w.y = cvt_pk_bf16(a2, a3); w.z = cvt_pk_bf16(a4, a5); w.w = cvt_pk_bf16(a6, a7); return __builtin_bit_cast(bf16x8, w);
}
__device__ __forceinline__ float rs_from_ssp(const GAS float* ssp, int row) {
    const GAS f32x4* p = (const GAS f32x4*)(ssp + (size_t)row * 16);
    const f32x4 a = p[0], b = p[1], c = p[2], d = p[3];
    const f32x4 s = (a + b) + (c + d);
    return __builtin_amdgcn_rsqf(((s.x + s.y) + (s.z + s.w)) * (1.f / 1024.f) + EPS);
}

__device__ __forceinline__ LAS float* rs_table() { __shared__ __attribute__((aligned(16))) float rs_tab[8 * 256]; return (LAS float*)rs_tab; }
namespace pg8 {
constexpr int BM = 256, BK = 64, HALF = 128, HTB = HALF * BK * 2, STAGE_BYTES = 8 * HTB, NXCD = 8, WGM = 4;
__host__ __device__ __forceinline__ int lds_byte(int r, int c) { const int st = (r >> 4) * 2 + (c >> 5), rr = r & 15, cc = c & 31, ob = rr * 64 + cc * 2; return st * 1024 + (ob ^ (((ob >> 9) & 1) << 5)); }
__host__ __device__ __forceinline__ void stage_rc(int b, int& R, int& C) { const int st = b / 1024, sb = b % 1024, swz = sb ^ (((sb >> 9) & 1) << 5); R = (st >> 1) * 16 + swz / 64; C = (st & 1) * 32 + (swz % 64) / 2; }
__host__ __device__ __forceinline__ int perm32(int rho) { const int n = rho >> 4, i = rho & 15; return 8 * (i >> 2) + 4 * n + (i & 3); }
struct Unit { int pm, pn; };
struct Gemm { const GAS bf16_t* A; const GAS bf16_t* Bt; int M, N, K; };
struct StaticOrder {
    int nM, nN, nwg, G, c;
    __host__ __device__ void init(int M, int N, int G_, int c_) { nM = M / BM; nN = N / BM; nwg = nM * nN; G = G_; c = c_; }
    __host__ __device__ bool next(int i, Unit& u) const {
        const long L = (long)i * G + c; if (L >= nwg) return false;
        int wgid = (int)L; { const int q = nwg / NXCD, r = nwg % NXCD, xcd = wgid % NXCD, off = wgid / NXCD; wgid = (xcd < r ? xcd * (q + 1) : r * (q + 1) + (xcd - r) * q) + off; }
        const int nig = WGM * nN, gid = wgid / nig, fm = gid * WGM, gsz = (nM - fm) < WGM ? (nM - fm) : WGM;
        u.pm = fm + ((wgid % nig) % gsz); u.pn = (wgid % nig) / gsz; return true;
    }
};
template <class Epi>
__device__ __forceinline__ void gemm_phase(LAS unsigned char* lds, const Gemm g, const StaticOrder& S, const Epi& E) {
    const int tid = opq_tid(), wid = __builtin_amdgcn_readfirstlane(tid >> 6), lane = tid & 63, wr = wid >> 2, wc = wid & 3, fr = lane & 15, fq = lane >> 4;
    LAS float* rsl = rs_table();
    if constexpr (Epi::USES_RS) { if (E.rs_src()) {
        const int hi = __builtin_amdgcn_readfirstlane(tid >> 8), rw = tid & 255;
        Unit u0; (void)S.next(0, u0);
#pragma unroll
        for (int j = 0; j < 4; ++j) { Unit uu; const int pmj = S.next(2 * j + hi, uu) ? uu.pm : u0.pm;
            rsl[(2 * j + hi) * 256 + rw] = rs_from_ssp(E.rs_src(), pmj * 256 + rw); } } }
    const int K = g.K, nt = K / BK;
    unsigned voffA[2], voffB[2];
#pragma unroll
    for (int i = 0; i < 2; ++i) { int R, C; stage_rc(tid * 16 + i * 8192, R, C); const int Rb = Epi::PERM ? ((R & ~31) + perm32(R & 31)) : R;
        voffA[i] = (unsigned)(R * K + C) * 2u; voffB[i] = (unsigned)(Rb * K + C) * 2u; }
    const size_t kstep = (size_t)(BK * 2);
    const size_t hstep = (size_t)HALF * K * 2;
    const size_t tstep = 2 * hstep;
    const unsigned ldsw = (unsigned)wid * 1024u;
    const int aoff = lds_byte(wr * 64 + fr, fq * 8), boff = lds_byte(wc * 32 + fr, fq * 8);
#define PG8_SA(b, h) (((b) * 2 + (h)) * HTB)
#define PG8_SB(b, h) ((4 + (b) * 2 + (h)) * HTB)
#define PG8_STAGE(bufoff, gbase, voff) do { _Pragma("unroll") for (int _i = 0; _i < 2; ++_i) \
        __builtin_amdgcn_global_load_lds((const GAS unsigned*)((const GAS char*)(gbase) + (voff)[_i]), (LAS unsigned*)(lds + (bufoff) + ldsw + _i * 8192), 16, 0, 0); } while (0)
#define PG8_LDA(dst, b, h) do { _Pragma("unroll") for (int m = 0; m < 4; ++m) _Pragma("unroll") for (int k = 0; k < 2; ++k) dst[m][k] = *(const LAS bf16x8*)(lds + PG8_SA(b, h) + aoff + m * 2048 + k * 1024); } while (0)
#define PG8_LDB(dst, b, h) do { _Pragma("unroll") for (int n = 0; n < 2; ++n) _Pragma("unroll") for (int k = 0; k < 2; ++k) dst[n][k] = *(const LAS bf16x8*)(lds + PG8_SB(b, h) + boff + n * 2048 + k * 1024); } while (0)
#define PG8_MMA(ai, bj, At, Bt) do { __builtin_amdgcn_s_setprio(1); _Pragma("unroll") for (int m = 0; m < 4; ++m) _Pragma("unroll") for (int n = 0; n < 2; ++n) _Pragma("unroll") for (int k = 0; k < 2; ++k) \
        acc[ai][bj][m][n] = __builtin_amdgcn_mfma_f32_16x16x32_bf16(Bt[n][k], At[m][k], acc[ai][bj][m][n], 0, 0, 0); __builtin_amdgcn_s_setprio(0); } while (0)
#define PG8_WAIT_V(n) asm volatile("s_waitcnt vmcnt(" #n ")" ::: "memory")
#define PG8_WAIT_L(n) asm volatile("s_waitcnt lgkmcnt(" #n ")" ::: "memory")
#define PG8_BAR __builtin_amdgcn_s_barrier()
#define PG8_SCHED __builtin_amdgcn_sched_barrier(0)
    Unit cur, nxt; int ui = 0;
    if (!S.next(0, cur)) return;
    f32x4 acc[2][2][4][2];
    if constexpr (Epi::HAS_INIT) E.init(acc, cur, wr, wc, fr, fq);
    else {
#pragma unroll
    for (int a = 0; a < 2; ++a)
#pragma unroll
        for (int b = 0; b < 2; ++b)
#pragma unroll
            for (int m = 0; m < 4; ++m)
#pragma unroll
                for (int n = 0; n < 2; ++n) acc[a][b][m][n] = (f32x4){0.f, 0.f, 0.f, 0.f};
    }
    bf16x8 At[4][2], B0[2][2], B1[2][2];
    const GAS char* cA = (const GAS char*)g.A + (size_t)cur.pm * tstep; const GAS char* cB = (const GAS char*)g.Bt + (size_t)cur.pn * tstep;
    PG8_STAGE(PG8_SB(0, 0), cB, voffB); PG8_STAGE(PG8_SB(0, 1), cB + hstep, voffB); PG8_STAGE(PG8_SA(0, 0), cA, voffA); PG8_STAGE(PG8_SA(0, 1), cA + hstep, voffA);
    if (wr == 1) PG8_BAR;
    PG8_WAIT_V(2); PG8_BAR;
    PG8_STAGE(PG8_SB(1, 0), cB + kstep, voffB); PG8_STAGE(PG8_SA(1, 0), cA + kstep, voffA); PG8_STAGE(PG8_SB(1, 1), cB + hstep + kstep, voffB);
    PG8_WAIT_V(6); PG8_BAR;
    for (;;) {
        const bool has_next = S.next(ui + 1, nxt);
        const GAS char* nA = has_next ? (const GAS char*)g.A + (size_t)nxt.pm * tstep : cA; const GAS char* nB = has_next ? (const GAS char*)g.Bt + (size_t)nxt.pn * tstep : cB;
        for (int t = 0; t < nt; t += 2) {
            const bool last = (t == nt - 2);
            const GAS char* a1 = cA + (size_t)(t + 1) * kstep;
            const GAS char* a2 = last ? nA : cA + (size_t)(t + 2) * kstep; const GAS char* b2 = last ? nB : cB + (size_t)(t + 2) * kstep;
            const GAS char* a3 = a2 + kstep; const GAS char* b3 = b2 + kstep;
            PG8_LDB(B0, 0, 0); PG8_LDB(B1, 0, 1); PG8_SCHED; PG8_LDA(At, 0, 0); PG8_STAGE(PG8_SA(1, 1), a1 + hstep, voffA);
            PG8_WAIT_V(8); PG8_WAIT_L(0); PG8_BAR; PG8_MMA(0, 0, At, B0); PG8_MMA(0, 1, At, B1); PG8_BAR; PG8_SCHED;
            PG8_LDA(At, 0, 1); PG8_STAGE(PG8_SB(0, 0), b2, voffB); PG8_STAGE(PG8_SB(0, 1), b2 + hstep, voffB); PG8_STAGE(PG8_SA(0, 0), a2, voffA);
            PG8_WAIT_V(8); PG8_WAIT_L(0); PG8_BAR; PG8_MMA(1, 0, At, B0); PG8_MMA(1, 1, At, B1); PG8_BAR; PG8_SCHED;
            PG8_LDB(B0, 1, 0); PG8_LDB(B1, 1, 1); PG8_SCHED; PG8_LDA(At, 1, 0); PG8_STAGE(PG8_SA(0, 1), a2 + hstep, voffA);
            PG8_WAIT_V(8); PG8_WAIT_L(0); PG8_BAR; PG8_MMA(0, 0, At, B0); PG8_MMA(0, 1, At, B1); PG8_BAR; PG8_SCHED;
            PG8_LDA(At, 1, 1); PG8_STAGE(PG8_SB(1, 0), b3, voffB); PG8_STAGE(PG8_SB(1, 1), b3 + hstep, voffB); PG8_STAGE(PG8_SA(1, 0), a3, voffA);
            PG8_WAIT_V(8); PG8_WAIT_L(0); PG8_BAR; PG8_MMA(1, 0, At, B0); PG8_MMA(1, 1, At, B1); PG8_BAR; PG8_SCHED;
        }
        if (wr == 0) PG8_BAR;
        E(acc, cur, wr, wc, fr, fq, rsl + (ui & 7) * 256);
        if (!has_next) break;
        if constexpr (Epi::HAS_INIT) E.init(acc, nxt, wr, wc, fr, fq);
        else {
#pragma unroll
        for (int a = 0; a < 2; ++a)
#pragma unroll
            for (int b = 0; b < 2; ++b)
#pragma unroll
                for (int m = 0; m < 4; ++m)
#pragma unroll
                    for (int n = 0; n < 2; ++n) acc[a][b][m][n] = (f32x4){0.f, 0.f, 0.f, 0.f};
        }
        cur = nxt; cA = nA; cB = nB; ++ui;
        if (wr == 1) PG8_BAR;
    }
    PG8_WAIT_V(0);
    PG8_BAR;
#undef PG8_SA
#undef PG8_SB
#undef PG8_STAGE
#undef PG8_LDA
#undef PG8_LDB
#undef PG8_MMA
#undef PG8_WAIT_V
#undef PG8_WAIT_L
#undef PG8_BAR
#undef PG8_SCHED
}
}
using pg8::Unit;
typedef const f32x4 (&AccRef)[2][2][4][2];

struct EpiBf16Scale {
    static constexpr bool PERM = true, HAS_INIT = false, USES_RS = true;
    GAS bf16_t* O; int ldc; const GAS float* ssp;
    __device__ __forceinline__ const GAS float* rs_src() const { return ssp; }
    __device__ __forceinline__ void operator()(AccRef acc, const Unit& u, int wr, int wc, int fr, int fq, const LAS float* rsl) const {
        const int row0 = u.pm * 256 + wr * 64 + fr, col0 = u.pn * 256 + wc * 32 + 8 * fq;
#pragma unroll
        for (int ai = 0; ai < 2; ++ai)
#pragma unroll
            for (int m = 0; m < 4; ++m) {
                const int row = row0 + ai * 128 + m * 16;
                const float rs = ssp ? rsl[ai * 128 + wr * 64 + m * 16 + fr] : 1.f;
                GAS bf16_t* rowp = O + (size_t)row * ldc + col0;
#pragma unroll
                for (int bj = 0; bj < 2; ++bj) {
                    const f32x4 v0 = acc[ai][bj][m][0] * rs, v1 = acc[ai][bj][m][1] * rs;
                    u32x4 w; w.x = cvt_pk_bf16(v0[0], v0[1]); w.y = cvt_pk_bf16(v0[2], v0[3]); w.z = cvt_pk_bf16(v1[0], v1[1]); w.w = cvt_pk_bf16(v1[2], v1[3]);
                    *(GAS u32x4*)(rowp + bj * 128) = w;
                }
            }
    }
};
__device__ __forceinline__ float sq8(const u32x4 w) {
    const float a0 = bf_lo(w.x), a1 = bf_hi(w.x), a2 = bf_lo(w.y), a3 = bf_hi(w.y), a4 = bf_lo(w.z), a5 = bf_hi(w.z), a6 = bf_lo(w.w), a7 = bf_hi(w.w);
    return ((a0 * a0 + a1 * a1) + (a2 * a2 + a3 * a3)) + ((a4 * a4 + a5 * a5) + (a6 * a6 + a7 * a7));
}
struct EpiRes {
    static constexpr bool PERM = true, HAS_INIT = true, USES_RS = false;
    GAS bf16_t* XB; GAS float* sso;
    __device__ __forceinline__ const GAS float* rs_src() const { return nullptr; }
    __device__ __forceinline__ void init(f32x4 (&acc)[2][2][4][2], const Unit& u, int wr, int wc, int fr, int fq) const {
        const int row0 = u.pm * 256 + wr * 64 + fr, col0 = u.pn * 256 + wc * 32 + 8 * fq;
#pragma unroll
        for (int ai = 0; ai < 2; ++ai)
#pragma unroll
            for (int m = 0; m < 4; ++m)
#pragma unroll
                for (int bj = 0; bj < 2; ++bj) {
                    const u32x4 xw = *(const GAS u32x4*)(XB + (size_t)(row0 + ai * 128 + m * 16) * D + col0 + bj * 128);
                    acc[ai][bj][m][0] = (f32x4){bf_lo(xw.x), bf_hi(xw.x), bf_lo(xw.y), bf_hi(xw.y)};
                    acc[ai][bj][m][1] = (f32x4){bf_lo(xw.z), bf_hi(xw.z), bf_lo(xw.w), bf_hi(xw.w)};
                }
    }
    __device__ __forceinline__ void operator()(AccRef acc, const Unit& u, int wr, int wc, int fr, int fq, const LAS float* rsl) const {
        const int row0 = u.pm * 256 + wr * 64 + fr, col0 = u.pn * 256 + wc * 32 + 8 * fq;
#pragma unroll
        for (int ai = 0; ai < 2; ++ai)
#pragma unroll
            for (int m = 0; m < 4; ++m) {
                const int row = row0 + ai * 128 + m * 16;
                float sq = 0.f;
#pragma unroll
                for (int bj = 0; bj < 2; ++bj) {
                    const f32x4 a0 = acc[ai][bj][m][0], a1 = acc[ai][bj][m][1];
                    u32x4 w; w.x = cvt_pk_bf16(a0[0], a0[1]); w.y = cvt_pk_bf16(a0[2], a0[3]); w.z = cvt_pk_bf16(a1[0], a1[1]); w.w = cvt_pk_bf16(a1[2], a1[3]);
                    *(GAS u32x4*)(XB + (size_t)row * D + col0 + bj * 128) = w;
                    sq += sq8(w);
                }
                sq += __shfl_xor(sq, 16); sq += __shfl_xor(sq, 32);
                if (fq == 0) sso[(size_t)row * 16 + u.pn * 4 + wc] = sq;
            }
    }
};
struct EpiPL {
    static constexpr bool PERM = true, HAS_INIT = false, USES_RS = true;
    const GAS bf16_t* XI; GAS bf16_t* XO; const GAS float* ssi; GAS float* sso; const GAS bf16_t* PP;
    __device__ __forceinline__ const GAS float* rs_src() const { return ssi; }
    __device__ __forceinline__ void operator()(AccRef acc, const Unit& u, int wr, int wc, int fr, int fq, const LAS float* rsl) const {
        const int row0 = u.pm * 256 + wr * 64 + fr, col0 = u.pn * 256 + wc * 32 + 8 * fq;
        u32x4 xw[2], pw[2];
        { const size_t off = (size_t)row0 * D + col0; xw[0] = *(const GAS u32x4*)(XI + off); pw[0] = *(const GAS u32x4*)(PP + off); }
        float sq = 0.f;
#pragma unroll
        for (int t = 0; t < 16; ++t) {
            const int ai = t >> 3, m = (t >> 1) & 3, bj = t & 1;
            const int row = row0 + ai * 128 + m * 16;
            const size_t off = (size_t)row * D + col0 + bj * 128;
            if (t < 15) { const int t1 = t + 1, ai1 = t1 >> 3, m1 = (t1 >> 1) & 3, bj1 = t1 & 1;
                const size_t off1 = (size_t)(row0 + ai1 * 128 + m1 * 16) * D + col0 + bj1 * 128;
                xw[t1 & 1] = *(const GAS u32x4*)(XI + off1); pw[t1 & 1] = *(const GAS u32x4*)(PP + off1); }
            const float rs = rsl[ai * 128 + wr * 64 + m * 16 + fr];
            const u32x4 xv = xw[t & 1], pv = pw[t & 1];
            const f32x4 g0 = acc[ai][bj][m][0] * rs, g1 = acc[ai][bj][m][1] * rs;
            u32x4 w;
            w.x = cvt_pk_bf16(bf_lo(xv.x) + fast_sigmoid(g0[0]) * bf_lo(pv.x), bf_hi(xv.x) + fast_sigmoid(g0[1]) * bf_hi(pv.x));
            w.y = cvt_pk_bf16(bf_lo(xv.y) + fast_sigmoid(g0[2]) * bf_lo(pv.y), bf_hi(xv.y) + fast_sigmoid(g0[3]) * bf_hi(pv.y));
            w.z = cvt_pk_bf16(bf_lo(xv.z) + fast_sigmoid(g1[0]) * bf_lo(pv.z), bf_hi(xv.z) + fast_sigmoid(g1[1]) * bf_hi(pv.z));
            w.w = cvt_pk_bf16(bf_lo(xv.w) + fast_sigmoid(g1[2]) * bf_lo(pv.w), bf_hi(xv.w) + fast_sigmoid(g1[3]) * bf_hi(pv.w));
            *(GAS u32x4*)(XO + off) = w;
            sq += sq8(w);
            if (bj == 1) {
                sq += __shfl_xor(sq, 16); sq += __shfl_xor(sq, 32);
                if (fq == 0) sso[(size_t)row * 16 + u.pn * 4 + wc] = sq;
                sq = 0.f;
            }
        }
    }
};
struct EpiRetIn {
    static constexpr bool PERM = true, HAS_INIT = false, USES_RS = true;
    GAS bf16_t* O; const GAS float* ssp; const GAS float* cosT; const GAS float* sinT; GAS bf16_t* QF;
    __device__ __forceinline__ const GAS float* rs_src() const { return ssp; }
    __device__ __forceinline__ void operator()(AccRef acc, const Unit& u, int wr, int wc, int fr, int fq, const LAS float* rsl) const {
        const int row0 = u.pm * 256 + wr * 64 + fr, col0 = u.pn * 256 + wc * 32 + 8 * fq;
        const int pn = u.pn;
        f32x4 csb[2][2], snb[2][2];
        if (pn < 8) { const size_t tb = (size_t)(row0 & (SEQ - 1)) * 128 + wc * 32 + 8 * fq;
            csb[0][0] = *(const GAS f32x4*)(cosT + tb); csb[0][1] = *(const GAS f32x4*)(cosT + tb + 4); snb[0][0] = *(const GAS f32x4*)(sinT + tb); snb[0][1] = *(const GAS f32x4*)(sinT + tb + 4); }
#pragma unroll
        for (int ai = 0; ai < 2; ++ai)
#pragma unroll
            for (int m = 0; m < 4; ++m) {
                const int row = row0 + ai * 128 + m * 16;
                const float rs = rsl[ai * 128 + wr * 64 + m * 16 + fr];
                GAS bf16_t* rowp = O + (size_t)row * 6144 + col0;
                if (pn < 8) {
                    const int pos = row & (SEQ - 1);
                    const float ksc = (pn >= 4) ? 0.0625f : 1.f;
                    const int tcur = ai * 4 + m;
                    if (tcur < 7) { const int t1 = tcur + 1; const size_t tb = (size_t)((row0 + (t1 >> 2) * 128 + (t1 & 3) * 16) & (SEQ - 1)) * 128 + wc * 32 + 8 * fq;
                        csb[t1 & 1][0] = *(const GAS f32x4*)(cosT + tb); csb[t1 & 1][1] = *(const GAS f32x4*)(cosT + tb + 4); snb[t1 & 1][0] = *(const GAS f32x4*)(sinT + tb); snb[t1 & 1][1] = *(const GAS f32x4*)(sinT + tb + 4); }
                    f32x4 o1[2], o2[2];
#pragma unroll
                    for (int n = 0; n < 2; ++n) {
                        const f32x4 cs = csb[tcur & 1][n], sn = snb[tcur & 1][n];
                        const f32x4 v1 = acc[ai][0][m][n] * rs, v2 = acc[ai][1][m][n] * rs;
                        o1[n] = (v1 * cs - v2 * sn) * ksc; o2[n] = (v2 * cs + v1 * sn) * ksc;
                    }
                    u32x4 w, w2; w.x = cvt_pk_bf16(o1[0][0], o1[0][1]); w.y = cvt_pk_bf16(o1[0][2], o1[0][3]); w.z = cvt_pk_bf16(o1[1][0], o1[1][1]); w.w = cvt_pk_bf16(o1[1][2], o1[1][3]);
                    w2.x = cvt_pk_bf16(o2[0][0], o2[0][1]); w2.y = cvt_pk_bf16(o2[0][2], o2[0][3]); w2.z = cvt_pk_bf16(o2[1][0], o2[1][1]); w2.w = cvt_pk_bf16(o2[1][2], o2[1][3]);
                    if (pn < 4) {
                        const int bq = row >> 11, nq = (pos >> 7), cq = pos & 127, ctq = cq >> 5, rq = cq & 31;
                        const size_t fb = ((((size_t)(bq * 4 + pn) * 16 + nq) * 4 + ctq) * 16 + 2 * wc + (fq >> 1)) * 2 + (fq & 1);
                        *(GAS u32x4*)(QF + (fb * 32 + rq) * 8) = w;
                        *(GAS u32x4*)(QF + ((fb + 16) * 32 + rq) * 8) = w2;
                    } else {
                        *(GAS u32x4*)(rowp) = w;
                        *(GAS u32x4*)(rowp + 128) = w2;
                    }
                } else {
#pragma unroll
                    for (int bj = 0; bj < 2; ++bj) {
                        f32x4 v0 = acc[ai][bj][m][0] * rs, v1 = acc[ai][bj][m][1] * rs;
                        if (pn >= 16) {
#pragma unroll
                            for (int e = 0; e < 4; ++e) { v0[e] = v0[e] * fast_sigmoid(v0[e]); v1[e] = v1[e] * fast_sigmoid(v1[e]); }
                        }
                        u32x4 w; w.x = cvt_pk_bf16(v0[0], v0[1]); w.y = cvt_pk_bf16(v0[2], v0[3]); w.z = cvt_pk_bf16(v1[0], v1[1]); w.w = cvt_pk_bf16(v1[2], v1[3]);
                        *(GAS u32x4*)(rowp + bj * 128) = w;
                    }
                }
            }
    }
};
struct EpiSguIn {
    static constexpr bool PERM = true, HAS_INIT = false, USES_RS = true;
    GAS bf16_t* O; const GAS float* ssp; GAS float* ssv;
    __device__ __forceinline__ const GAS float* rs_src() const { return ssp; }
    __device__ __forceinline__ void operator()(AccRef acc, const Unit& u, int wr, int wc, int fr, int fq, const LAS float* rsl) const {
        const int row0 = u.pm * 256 + wr * 64 + fr, col0 = u.pn * 256 + wc * 32 + 8 * fq;
#pragma unroll
        for (int ai = 0; ai < 2; ++ai)
#pragma unroll
            for (int m = 0; m < 4; ++m) {
                const int row = row0 + ai * 128 + m * 16;
                const float rs = rsl[ai * 128 + wr * 64 + m * 16 + fr];
                GAS bf16_t* rowp = O + (size_t)row * 4096 + col0;
                float sq = 0.f;
#pragma unroll
                for (int bj = 0; bj < 2; ++bj) {
                    f32x4 v0 = acc[ai][bj][m][0] * rs, v1 = acc[ai][bj][m][1] * rs;
#pragma unroll
                    for (int e = 0; e < 4; ++e) { v0[e] = gelu_tanh(v0[e]); v1[e] = gelu_tanh(v1[e]); }
                    u32x4 w; w.x = cvt_pk_bf16(v0[0], v0[1]); w.y = cvt_pk_bf16(v0[2], v0[3]); w.z = cvt_pk_bf16(v1[0], v1[1]); w.w = cvt_pk_bf16(v1[2], v1[3]);
                    *(GAS u32x4*)(rowp + bj * 128) = w;
                    sq += (v0[0] * v0[0] + v0[1] * v0[1]) + (v0[2] * v0[2] + v0[3] * v0[3]) + (v1[0] * v1[0] + v1[1] * v1[1]) + (v1[2] * v1[2] + v1[3] * v1[3]);
                }
                if (u.pn >= 8) {
                    sq += __shfl_xor(sq, 16); sq += __shfl_xor(sq, 32);
                    if (fq == 0) ssv[(size_t)row * 32 + (u.pn - 8) * 4 + wc] = sq;
                }
            }
    }
};


__device__ __forceinline__ float dpp_ror1(float v) { return __builtin_bit_cast(float, __builtin_amdgcn_update_dpp(0, __builtin_bit_cast(int, v), 0x121, 0xf, 0xf, false)); }
__device__ __forceinline__ float dpp_ror2(float v) { return __builtin_bit_cast(float, __builtin_amdgcn_update_dpp(0, __builtin_bit_cast(int, v), 0x122, 0xf, 0xf, false)); }
struct EpiFfnConv {
    static constexpr bool PERM = true, HAS_INIT = false, USES_RS = true;
    GAS bf16_t* ACT; const GAS float* ssp; const GAS float* cw; const GAS float* cb; GAS float* SG; GAS float* SU;
    __device__ __forceinline__ const GAS float* rs_src() const { return ssp; }
    __device__ __forceinline__ void operator()(AccRef acc, const Unit& u, int wr, int wc, int fr, int fq, const LAS float* rsl) const {
        const int f0 = u.pn * 128 + wc * 32 + 8 * fq;
        float w0[8], w1[8], w2[8], bb[8];
        { const f32x4 t0 = *(const GAS f32x4*)(cw + f0), t1 = *(const GAS f32x4*)(cw + f0 + 4);
          const f32x4 t2 = *(const GAS f32x4*)(cw + FFN + f0), t3 = *(const GAS f32x4*)(cw + FFN + f0 + 4);
          const f32x4 t4 = *(const GAS f32x4*)(cw + 2 * FFN + f0), t5 = *(const GAS f32x4*)(cw + 2 * FFN + f0 + 4);
          const f32x4 t6 = *(const GAS f32x4*)(cb + f0), t7 = *(const GAS f32x4*)(cb + f0 + 4);
#pragma unroll
          for (int e = 0; e < 4; ++e) { w0[e] = t0[e]; w0[4 + e] = t1[e]; w1[e] = t2[e]; w1[4 + e] = t3[e]; w2[e] = t4[e]; w2[4 + e] = t5[e]; bb[e] = t6[e]; bb[4 + e] = t7[e]; } }
#pragma unroll
        for (int ai = 0; ai < 2; ++ai) {
            const int blk64 = u.pm * 4 + ai * 2 + wr;
            float gp[8];
#pragma unroll
            for (int e = 0; e < 8; ++e) gp[e] = 0.f;
#pragma unroll
            for (int m = 0; m < 4; ++m) {
                const int row = u.pm * 256 + ai * 128 + wr * 64 + m * 16 + fr;
                const float rs = rsl[ai * 128 + wr * 64 + m * 16 + fr];
                const f32x4 g0 = acc[ai][0][m][0] * rs, g1v = acc[ai][0][m][1] * rs, u0 = acc[ai][1][m][0] * rs, u1 = acc[ai][1][m][1] * rs;
                float g[8], up[8], o[8];
#pragma unroll
                for (int e = 0; e < 4; ++e) { g[e] = g0[e]; g[4 + e] = g1v[e]; up[e] = u0[e]; up[4 + e] = u1[e]; }
                if (m == 0 && fr < 2) {
                    GAS float* sg = SG + ((size_t)blk64 * 4 + fr) * FFN + f0; GAS float* su = SU + ((size_t)blk64 * 2 + fr) * FFN + f0;
                    *(GAS f32x4*)sg = g0; *(GAS f32x4*)(sg + 4) = g1v; *(GAS f32x4*)su = u0; *(GAS f32x4*)(su + 4) = u1;
                }
                if (m == 3 && fr >= 14) {
                    GAS float* sg = SG + ((size_t)blk64 * 4 + 2 + (fr - 14)) * FFN + f0;
                    *(GAS f32x4*)sg = g0; *(GAS f32x4*)(sg + 4) = g1v;
                }
#pragma unroll
                for (int e = 0; e < 8; ++e) {
                    const float x1 = (fr == 15) ? gp[e] : g[e], x2 = (fr >= 14) ? gp[e] : g[e];
                    const float gm1 = dpp_ror1(x1), gm2 = dpp_ror2(x2);
                    const float cv = bb[e] + w0[e] * gm2 + w1[e] * gm1 + w2[e] * g[e];
                    o[e] = cv * fast_sigmoid(cv) * up[e];
                    gp[e] = g[e];
                }
                if (!(m == 0 && fr < 2)) {
                    u32x4 w; w.x = cvt_pk_bf16(o[0], o[1]); w.y = cvt_pk_bf16(o[2], o[3]); w.z = cvt_pk_bf16(o[4], o[5]); w.w = cvt_pk_bf16(o[6], o[7]);
                    *(GAS u32x4*)(ACT + (size_t)row * FFN + f0) = w;
                }
            }
        }
    }
};
__device__ __forceinline__ void ffn_fixup(GAS bf16_t* __restrict__ act, const GAS float* __restrict__ SG, const GAS float* __restrict__ SU, const GAS float* __restrict__ cw, const GAS float* __restrict__ cb, int pm) {
    constexpr int NCG = FFN / 8;
#pragma unroll 3
    for (int it = opq_tid(); it < 8 * NCG; it += 512) {
        const int bq = it / (2 * NCG), rem = it - bq * 2 * NCG, rr = rem / NCG, f0 = (rem - rr * NCG) * 8;
        const int blk64 = pm * 4 + bq, row = blk64 * 64 + rr;
        const bool first = ((blk64 * 64) & (SEQ - 1)) == 0;
        const GAS float* c0 = SG + ((size_t)blk64 * 4) * FFN + f0;
        const GAS float* pv = SG + ((size_t)(blk64 - 1) * 4 + 2) * FFN + f0;
        float gm2[8], gm1[8], gc[8], up[8];
#pragma unroll
        for (int e = 0; e < 8; ++e) { gm2[e] = 0.f; gm1[e] = 0.f; }
        if (rr == 0) {
            if (!first) { const f32x4 a = *(const GAS f32x4*)pv, b = *(const GAS f32x4*)(pv + 4), c = *(const GAS f32x4*)(pv + FFN), d = *(const GAS f32x4*)(pv + FFN + 4);
#pragma unroll
                for (int e = 0; e < 4; ++e) { gm2[e] = a[e]; gm2[4 + e] = b[e]; gm1[e] = c[e]; gm1[4 + e] = d[e]; } }
            const f32x4 a = *(const GAS f32x4*)c0, b = *(const GAS f32x4*)(c0 + 4);
#pragma unroll
            for (int e = 0; e < 4; ++e) { gc[e] = a[e]; gc[4 + e] = b[e]; }
        } else {
            if (!first) { const f32x4 c = *(const GAS f32x4*)(pv + FFN), d = *(const GAS f32x4*)(pv + FFN + 4);
#pragma unroll
                for (int e = 0; e < 4; ++e) { gm2[e] = c[e]; gm2[4 + e] = d[e]; } }
            const f32x4 a = *(const GAS f32x4*)c0, b = *(const GAS f32x4*)(c0 + 4), c = *(const GAS f32x4*)(c0 + FFN), d = *(const GAS f32x4*)(c0 + FFN + 4);
#pragma unroll
            for (int e = 0; e < 4; ++e) { gm1[e] = a[e]; gm1[4 + e] = b[e]; gc[e] = c[e]; gc[4 + e] = d[e]; }
        }
        { const GAS float* su = SU + ((size_t)blk64 * 2 + rr) * FFN + f0; const f32x4 a = *(const GAS f32x4*)su, b = *(const GAS f32x4*)(su + 4);
#pragma unroll
          for (int e = 0; e < 4; ++e) { up[e] = a[e]; up[4 + e] = b[e]; } }
        float o[8];
#pragma unroll
        for (int e = 0; e < 8; ++e) { const float cv = cb[f0 + e] + cw[f0 + e] * gm2[e] + cw[FFN + f0 + e] * gm1[e] + cw[2 * FFN + f0 + e] * gc[e]; o[e] = cv * fast_sigmoid(cv) * up[e]; }
        u32x4 w; w.x = cvt_pk_bf16(o[0], o[1]); w.y = cvt_pk_bf16(o[2], o[3]); w.z = cvt_pk_bf16(o[4], o[5]); w.w = cvt_pk_bf16(o[6], o[7]);
        *(GAS u32x4*)(act + (size_t)row * FFN + f0) = w;
    }
}

__device__ __forceinline__ void transpose_item(const GAS float* W, const GAS float* gain, int K, int N, GAS bf16_t* WT, LAS float* scr, int item, int lane, int perm) {
    const int nblk = N / 32, kb = item / nblk, nb = item % nblk, k0 = 64 * kb, n0 = 32 * nb;
    float wv[32];
#pragma unroll
    for (int i = 0; i < 32; ++i) { const int kk = 2 * i + (lane >> 5); wv[i] = W[(size_t)(k0 + kk) * N + n0 + (lane & 31)]; }
#pragma unroll
    for (int i = 0; i < 32; ++i) { const int kk = 2 * i + (lane >> 5); const float g = gain ? gain[k0 + kk] : 1.f; scr[kk * 33 + (lane & 31)] = wv[i] * g; }
    asm volatile("s_waitcnt lgkmcnt(0)" ::: "memory");
    const int c = lane & 7;
#pragma unroll
    for (int j = 0; j < 4; ++j) { const int n = (lane >> 3) + 8 * j; const LAS float* s = scr + (8 * c) * 33 + n;
        u32x4 o; o.x = cvt_pk_bf16(s[0 * 33], s[1 * 33]); o.y = cvt_pk_bf16(s[2 * 33], s[3 * 33]); o.z = cvt_pk_bf16(s[4 * 33], s[5 * 33]); o.w = cvt_pk_bf16(s[6 * 33], s[7 * 33]);
        int nr = n0 + n; if (perm) { const int isup = nr >= FFN, f = isup ? nr - FFN : nr; nr = (f >> 7) * 256 + (isup ? 128 : 0) + (f & 127); }
        *(GAS u32x4*)(WT + (size_t)nr * K + k0 + 8 * c) = o; }
    asm volatile("s_waitcnt lgkmcnt(0)" ::: "memory");
}
__device__ __forceinline__ void prep_phase(const Params& P, LAS unsigned char* lds, int G, int cblk) {
    const int tid = opq_tid(), lane = tid & 63, wave = __builtin_amdgcn_readfirstlane(tid >> 6);
    LAS float* scr = (LAS float*)(lds + wave * 16384);
    const int gw = cblk * 8 + wave, NGW = G * 8;
    int base = 0;
#pragma unroll 1
    for (int mi = 0; mi < 24; ++mi) {
        const GAS float* W = (const GAS float*)P.mats[mi].W; const GAS float* gain = (const GAS float*)P.mats[mi].gain; GAS bf16_t* dst = (GAS bf16_t*)P.mats[mi].dst; const int K = P.mats[mi].K, N = P.mats[mi].N, perm = P.mats[mi].perm;
        const int items = (K / 64) * (N / 32);
        int start = ((gw - base) % NGW + NGW) % NGW;
        for (int it = start; it < items; it += NGW) transpose_item(W, gain, K, N, dst, scr, it, lane, perm);
        base += items;
    }
    GAS float* cosT = (GAS float*)(P.ws + OFF_COS); GAS float* sinT = (GAS float*)(P.ws + OFF_SIN);
    for (int i = cblk * 512 + tid; i < SEQ * 128; i += G * 512) {
        const int pos = i >> 7, fi = i & 127;
        const double inv = exp(-(double)fi * (9.210340371976184 / 128.0));
        const double ang = (double)pos * inv;
        const double TWO_PI = 6.283185307179586476925;
        const double r = ang - rint(ang / TWO_PI) * TWO_PI;
        const double r2 = r * r;
        double s = 1.0 / 51090942171709440000.0;
        s = s * (-r2) + 1.0 / 121645100408832000.0; s = s * (-r2) + 1.0 / 355687428096000.0; s = s * (-r2) + 1.0 / 1307674368000.0; s = s * (-r2) + 1.0 / 6227020800.0;
        s = s * (-r2) + 1.0 / 39916800.0; s = s * (-r2) + 1.0 / 362880.0; s = s * (-r2) + 1.0 / 5040.0; s = s * (-r2) + 1.0 / 120.0; s = s * (-r2) + 1.0 / 6.0; s = s * (-r2) + 1.0;
        s *= r;
        double c = 1.0 / 2432902008176640000.0;
        c = c * (-r2) + 1.0 / 6402373705728000.0; c = c * (-r2) + 1.0 / 20922789888000.0; c = c * (-r2) + 1.0 / 87178291200.0; c = c * (-r2) + 1.0 / 479001600.0;
        c = c * (-r2) + 1.0 / 3628800.0; c = c * (-r2) + 1.0 / 40320.0; c = c * (-r2) + 1.0 / 720.0; c = c * (-r2) + 1.0 / 24.0; c = c * (-r2) + 0.5; c = c * (-r2) + 1.0;
        cosT[i] = (float)c; sinT[i] = (float)s;
    }
}

__device__ __forceinline__ void load_half_phase(const GAS float* xin, GAS bf16_t* xb, GAS float* sso, int G, int cblk) {
    const int tid = opq_tid(), lane = tid & 63, wave = tid >> 6;
    for (int row = cblk * 8 + wave; row < TH; row += G * 8) {
        const GAS f32x4* xr = (const GAS f32x4*)(xin + (size_t)row * D) + lane;
        GAS u32x2* bo = (GAS u32x2*)(xb + (size_t)row * D) + lane;
        float s = 0.f;
#pragma unroll
        for (int j = 0; j < 4; ++j) { const f32x4 v = xr[64 * j]; u32x2 w; w.x = cvt_pk_bf16(v.x, v.y); w.y = cvt_pk_bf16(v.z, v.w); bo[64 * j] = w;
            const float a0 = bf_lo(w.x), a1 = bf_hi(w.x), a2 = bf_lo(w.y), a3 = bf_hi(w.y); s += (a0 * a0 + a1 * a1) + (a2 * a2 + a3 * a3); }
        s = wave_sum(s);
        if (lane < 16) sso[(size_t)row * 16 + lane] = (lane == 0) ? s : 0.f;
    }
}
__device__ __forceinline__ void pconv_phase(const GAS float* __restrict__ pin, GAS bf16_t* __restrict__ pb, int G, int cblk) {
#pragma unroll 4
    for (int i = cblk * 512 + opq_tid(); i < TH * PLD / 8; i += G * 512) {
        const f32x4 a = *(const GAS f32x4*)(pin + (size_t)i * 8), b = *(const GAS f32x4*)(pin + (size_t)i * 8 + 4);
        u32x4 w; w.x = cvt_pk_bf16(a.x, a.y); w.y = cvt_pk_bf16(a.z, a.w); w.z = cvt_pk_bf16(b.x, b.y); w.w = cvt_pk_bf16(b.z, b.w);
        *(GAS u32x4*)(pb + (size_t)i * 8) = w;
    }
}
__device__ __forceinline__ void final_phase(const GAS bf16_t* xb, GAS float* out, const GAS float* gf, int G, int cblk) {
    const int tid = opq_tid(), lane = tid & 63, wave = tid >> 6;
    for (int row = cblk * 8 + wave; row < TH; row += G * 8) {
        const GAS u32x4* xr = (const GAS u32x4*)(xb + (size_t)row * D) + lane;
        GAS f32x4* orow = (GAS f32x4*)(out + (size_t)row * D);
        const u32x4 w0 = xr[0], w1 = xr[64];
        float s = wave_sum(sq8(w0) + sq8(w1));
        const float rs = 1.f / sqrtf(s * (1.f / 1024.f) + EPS);
#pragma unroll
        for (int j = 0; j < 2; ++j) {
            const u32x4 w = j ? w1 : w0;
            const int c0 = 8 * lane + 512 * j;
            const f32x4 ga = *(const GAS f32x4*)(gf + c0), gb = *(const GAS f32x4*)(gf + c0 + 4);
            f32x4 oa, ob;
            oa.x = bf_lo(w.x) * rs * ga.x; oa.y = bf_hi(w.x) * rs * ga.y; oa.z = bf_lo(w.y) * rs * ga.z; oa.w = bf_hi(w.y) * rs * ga.w;
            ob.x = bf_lo(w.z) * rs * gb.x; ob.y = bf_hi(w.z) * rs * gb.y; ob.z = bf_lo(w.w) * rs * gb.z; ob.w = bf_hi(w.w) * rs * gb.w;
            orow[c0 / 4] = oa; orow[c0 / 4 + 1] = ob;
        }
    }
}
template <int NKS>
__device__ __forceinline__ f32x16 lds_feed_mfma(LAS unsigned char* p, const bf16x8* bq, f32x16 acc) {
    static_assert(NKS % 2 == 0, "groups of two k-steps");
    bf16x8 a[2][2];
#pragma unroll
    for (int j = 0; j < 2; ++j) a[0][j] = *(const LAS bf16x8*)(p + 32 * j);
#pragma unroll
    for (int g = 0; g < NKS / 2; ++g) {
        if (g + 1 < NKS / 2) {
#pragma unroll
            for (int j = 0; j < 2; ++j) a[(g + 1) & 1][j] = *(const LAS bf16x8*)(p + 32 * (2 * (g + 1) + j));
        }
        __builtin_amdgcn_sched_barrier(0);
        __builtin_amdgcn_s_setprio(1);
#pragma unroll
        for (int j = 0; j < 2; ++j) acc = mfma32(a[g & 1][j], bq[2 * g + j], acc);
        __builtin_amdgcn_s_setprio(0);
        __builtin_amdgcn_sched_barrier(0);
    }
    return acc;
}
__device__ __forceinline__ void sb_tile_tail(const f32x16& s, const bool diag, const int r, const int hh, float& carry, f32x16 (&oacc)[2], LAS unsigned char* vt) {
    constexpr int RS_ = 144;
    const float C = 0.125f * LOG2E;
    float be[16], kp[16];
#pragma unroll
    for (int e2 = 0; e2 < 8; ++e2) {
        f32x2 sv; sv.x = s[2 * e2]; sv.y = s[2 * e2 + 1];
        const f32x2 z2 = sv * (-C);
        f32x2 ex; ex.x = __builtin_amdgcn_exp2f(z2.x); ex.y = __builtin_amdgcn_exp2f(z2.y);
        const f32x2 d = ex + 1.f;
        f32x2 b2; b2.x = __builtin_amdgcn_rcpf(d.x); b2.y = __builtin_amdgcn_rcpf(d.y);
        const f32x2 k2 = 1.f - b2;
        be[2 * e2] = b2.x; be[2 * e2 + 1] = b2.y; kp[2 * e2] = k2.x; kp[2 * e2 + 1] = k2.y;
    }
    if (diag) {
#pragma unroll
        for (int e = 0; e < 16; ++e) { const int kidx = 8 * (e >> 2) + 4 * hh + (e & 3); const bool valid = kidx < r; be[e] = valid ? be[e] : 0.f; kp[e] = valid ? kp[e] : 1.f; }
    }
    float Gs[4], PG[4];
#pragma unroll
    for (int i = 0; i < 4; ++i) { Gs[i] = (kp[4 * i] * kp[4 * i + 1]) * (kp[4 * i + 2] * kp[4 * i + 3]); PG[i] = __shfl_xor(Gs[i], 32); }
    float R[4]; R[3] = 1.f; R[2] = Gs[3] * PG[3]; R[1] = R[2] * (Gs[2] * PG[2]); R[0] = R[1] * (Gs[1] * PG[1]);
    const float tot = R[0] * (Gs[0] * PG[0]);
    float A[16];
#pragma unroll
    for (int i = 0; i < 4; ++i) {
        const float b3 = carry * R[i] * (hh == 0 ? PG[i] : 1.f);
        const float b2 = b3 * kp[4 * i + 3], b1 = b2 * kp[4 * i + 2], b0 = b1 * kp[4 * i + 1];
        A[4 * i + 3] = be[4 * i + 3] * b3; A[4 * i + 2] = be[4 * i + 2] * b2; A[4 * i + 1] = be[4 * i + 1] * b1; A[4 * i] = be[4 * i] * b0;
    }
    carry *= tot;
    const bf16x8 pf0 = pack8(A[0], A[1], A[2], A[3], A[4], A[5], A[6], A[7]), pf1 = pack8(A[8], A[9], A[10], A[11], A[12], A[13], A[14], A[15]);
#pragma unroll
    for (int dvt = 0; dvt < 2; ++dvt) {
        const bf16x8 a0 = cat4(tr_read(vt + dvt * 64), tr_read(vt + dvt * 64 + 8 * RS_));
        const bf16x8 a1 = cat4(tr_read(vt + dvt * 64 + 16 * RS_), tr_read(vt + dvt * 64 + 24 * RS_));
        oacc[dvt] = mfma32(a0, pf0, oacc[dvt]);
        oacc[dvt] = mfma32(a1, pf1, oacc[dvt]);
    }
}
__device__ __forceinline__ f32x16 sb_tile_qk(LAS unsigned char* kt, const bf16x8 (&qf)[4]) {
    f32x16 s;
#pragma unroll
    for (int e = 0; e < 16; ++e) s[e] = 0.f;
    s = lds_feed_mfma<4>(kt, qf, s);
    return s;
}
__device__ __forceinline__ void sb_attn_phase(const GAS bf16_t* qkv, GAS bf16_t* o, LAS unsigned char* lds, int G, int cblk) {
    const int tid = opq_tid(), lane = tid & 63, w = __builtin_amdgcn_readfirstlane(tid >> 6), r = lane & 31, hh = lane >> 5;
    const int blk = (lane >> 4) & 1, tq = (lane & 15) >> 2, tp = lane & 3;
    constexpr int RS_ = 144, CH = 128, BUF = CH * RS_;
    LAS unsigned char* Kb = lds; LAS unsigned char* Vb = lds + 2 * BUF;
    const int srow = tid >> 3, spc = tid & 7;
#pragma unroll 1
    for (int u = cblk; u < 1024; u += G) {
        const int grp = u >> 7, qb = (0x10235467u >> (4 * grp)) & 7, bh = u & 127, b = bh >> 4, h = bh & 15;
        const size_t seq0 = (size_t)b * SEQ;
        const int Q0 = qb * 256 + 32 * ((w < 4) ? w : 11 - w);
        bf16x8 qf[4];
#pragma unroll
        for (int ks = 0; ks < 4; ++ks) qf[ks] = *(const GAS bf16x8*)(qkv + (seq0 + Q0 + r) * 3072 + h * 64 + 16 * ks + 8 * hh);
        f32x16 oacc[2];
#pragma unroll
        for (int e = 0; e < 16; ++e) { oacc[0][e] = 0.f; oacc[1][e] = 0.f; }
        float carry = 1.f;
        const int nch = qb * 2 + 2;
        volatile LAS unsigned* flg = (volatile LAS unsigned*)(lds + 131072 + 64);
        if (tid < 3) flg[tid] = 0u;
#pragma unroll
        for (int i = 0; i < 2; ++i) { const GAS bf16_t* gk = qkv + (seq0 + (size_t)(nch - 1) * CH + srow + 64 * i) * 3072 + 1024 + h * 64 + spc * 8;
          const u32x4 kq = *(const GAS u32x4*)gk, vq = *(const GAS u32x4*)(gk + 1024);
          *(LAS u32x4*)(Kb + (srow + 64 * i) * RS_ + spc * 16) = kq; *(LAS u32x4*)(Vb + (srow + 64 * i) * RS_ + spc * 16) = vq; }
        LDS_BARRIER();
        bool walive = true;
        int fi = 0;
#pragma unroll 1
        for (int kc = nch - 1; kc >= 0; --kc) {
            const int buf = (nch - 1 - kc) & 1;
            const int fnx = (fi == 2) ? 0 : fi + 1;
            if (tid == 0) flg[fnx] = 0u;
            u32x4 kq[2], vq[2];
            if (kc > 0) {
#pragma unroll
                for (int i = 0; i < 2; ++i) { const GAS bf16_t* gk = qkv + (seq0 + (size_t)(kc - 1) * CH + srow + 64 * i) * 3072 + 1024 + h * 64 + spc * 8; kq[i] = *(const GAS u32x4*)gk; vq[i] = *(const GAS u32x4*)(gk + 1024); }
            }
            if (walive) {
                LAS unsigned char* kt0 = Kb + buf * BUF + r * RS_ + 16 * hh;
                LAS unsigned char* vt0 = Vb + buf * BUF + (4 * hh + tq) * RS_ + (16 * blk + 4 * tp) * 2;
                if (kc * CH + 96 < Q0) {
                    f32x16 sv[4];
#pragma unroll
                    for (int tl = 0; tl < 4; ++tl) sv[tl] = sb_tile_qk(kt0 + 32 * tl * RS_, qf);
#pragma unroll
                    for (int tl = 3; tl >= 0; --tl) sb_tile_tail(sv[tl], false, r, hh, carry, oacc, vt0 + 32 * tl * RS_);
                } else {
#pragma unroll 1
                    for (int tl = 3; tl >= 0; --tl) {
                        const int ks0 = kc * CH + 32 * tl;
                        if (ks0 > Q0) continue;
                        const f32x16 s = sb_tile_qk(kt0 + 32 * tl * RS_, qf);
                        sb_tile_tail(s, ks0 == Q0, r, hh, carry, oacc, vt0 + 32 * tl * RS_);
                    }
                }
                walive = __builtin_amdgcn_ballot_w64(carry != 0.f) != 0ull;
                if (walive && lane == 0) flg[fi] = 1u;
            }
            if (kc > 0) {
#pragma unroll
                for (int i = 0; i < 2; ++i) { *(LAS u32x4*)(Kb + (buf ^ 1) * BUF + (srow + 64 * i) * RS_ + spc * 16) = kq[i]; *(LAS u32x4*)(Vb + (buf ^ 1) * BUF + (srow + 64 * i) * RS_ + spc * 16) = vq[i]; }
            }
            LDS_BARRIER();
            if (flg[fi] == 0u) break;
            fi = fnx;
        }
        LDS_BARRIER();
        GAS bf16_t* op = o + (seq0 + Q0 + r) * D + h * 64 + 4 * hh;
#pragma unroll
        for (int dvt = 0; dvt < 2; ++dvt)
#pragma unroll
            for (int i = 0; i < 4; ++i) {
                u32x2 wv; wv.x = cvt_pk_bf16(oacc[dvt][4 * i], oacc[dvt][4 * i + 1]); wv.y = cvt_pk_bf16(oacc[dvt][4 * i + 2], oacc[dvt][4 * i + 3]);
                *(GAS u32x2*)(op + 32 * dvt + 8 * i) = wv;
            }
    }
}

__device__ __forceinline__ void ret_core_phase(const GAS bf16_t* proj, const GAS bf16_t* QF, GAS bf16_t* oraw, GAS float* rst, LAS unsigned char* lds, int G, int cblk) {
    const int tid = opq_tid(), lane = tid & 63, w = __builtin_amdgcn_readfirstlane(tid >> 6), r = lane & 31, hh = lane >> 5;
    const int blk = (lane >> 4) & 1, tq = (lane & 15) >> 2, tp = lane & 3;
    constexpr int KSTR = 528, VSTR = 272;
    LAS unsigned char* KS = lds; LAS unsigned char* VT = lds + 128 * KSTR; LAS unsigned char* ST = lds + 128 * KSTR + 64 * VSTR;
    const int ct = (w < 4) ? w : 7 - w, et = w >> 2;
#pragma unroll 1
    for (int u0 = cblk; u0 < 256; u0 += G) {
        const int u = ((G & 7) == 0 && G <= 256) ? ((((u0 & 7) * 4 + ((u0 >> 3) >> 3)) << 3) | ((u0 >> 3) & 7)) : u0;
        const int b = u >> 5, h = (u >> 3) & 3, es = u & 7;
        const float lg2 = log2f(1.f - exp2f(-5.f - (float)h));
        f32x16 Sacc[2];
#pragma unroll
        for (int e = 0; e < 16; ++e) { Sacc[0][e] = 0.f; Sacc[1][e] = 0.f; }
        u32x4 kreg[8]; bf16x8 qf[16];
        {
            const size_t tk = (size_t)b * SEQ;
#pragma unroll
            for (int i = 0; i < 8; ++i) { const int id = tid + 512 * i, row = id >> 5, pc = id & 31; kreg[i] = *(const GAS u32x4*)(proj + (tk + row) * 6144 + 1024 + h * 256 + pc * 8); }
#pragma unroll
            for (int ks = 0; ks < 16; ++ks) qf[ks] = *(const GAS bf16x8*)(QF + ((((((size_t)(b * 4 + h) * 16 + 0) * 4 + ct) * 16 + ks) * 2 + hh) * 32 + r) * 8);
        }
#pragma unroll 1
        for (int n = 0; n < 16; ++n) {
            const size_t tok0 = (size_t)b * SEQ + n * 128;
            u32x4 vqq[2];
#pragma unroll
            for (int i = 0; i < 2; ++i) { const int id = tid + 512 * i, m = id & 127, pc = id >> 7; vqq[i] = *(const GAS u32x4*)(proj + (tok0 + m) * 6144 + 2048 + h * 512 + es * 64 + pc * 8); }
#pragma unroll
            for (int i = 0; i < 8; ++i) { const int id = tid + 512 * i, row = id >> 5, pc = id & 31; *(LAS u32x4*)(KS + row * KSTR + pc * 16) = kreg[i]; }
#pragma unroll
            for (int i = 0; i < 2; ++i) { const int id = tid + 512 * i, m = id & 127, pc = id >> 7;
                const u32x4 vq = vqq[i];
                const float sc = exp2f(-lg2 * (float)(m + 1));
                const unsigned w0 = cvt_pk_bf16(bf_lo(vq.x) * sc, bf_hi(vq.x) * sc), w1 = cvt_pk_bf16(bf_lo(vq.y) * sc, bf_hi(vq.y) * sc),
                               w2 = cvt_pk_bf16(bf_lo(vq.z) * sc, bf_hi(vq.z) * sc), w3 = cvt_pk_bf16(bf_lo(vq.w) * sc, bf_hi(vq.w) * sc);
                LAS unsigned char* vp = VT + (pc * 8) * VSTR + m * 2;
                *(LAS bf16_t*)(vp + 0 * VSTR) = (bf16_t)(w0 & 0xffff); *(LAS bf16_t*)(vp + 1 * VSTR) = (bf16_t)(w0 >> 16);
                *(LAS bf16_t*)(vp + 2 * VSTR) = (bf16_t)(w1 & 0xffff); *(LAS bf16_t*)(vp + 3 * VSTR) = (bf16_t)(w1 >> 16);
                *(LAS bf16_t*)(vp + 4 * VSTR) = (bf16_t)(w2 & 0xffff); *(LAS bf16_t*)(vp + 5 * VSTR) = (bf16_t)(w2 >> 16);
                *(LAS bf16_t*)(vp + 6 * VSTR) = (bf16_t)(w3 & 0xffff); *(LAS bf16_t*)(vp + 7 * VSTR) = (bf16_t)(w3 >> 16); }
            if (n < 15) {
                const size_t tn = tok0 + 128;
#pragma unroll
                for (int i = 0; i < 8; ++i) { const int id = tid + 512 * i, row = id >> 5, pc = id & 31; kreg[i] = *(const GAS u32x4*)(proj + (tn + row) * 6144 + 1024 + h * 256 + pc * 8); }
            }
            LDS_BARRIER();
            f32x16 oacc;
#pragma unroll
            for (int e = 0; e < 16; ++e) oacc[e] = 0.f;
            if (n > 0) {
                LAS unsigned char* sp = ST + (32 * et + r) * KSTR + 16 * hh;
                oacc = lds_feed_mfma<16>(sp, qf, oacc);
            }
#pragma unroll 1
            for (int mt = 0; mt <= ct; ++mt) {
                f32x16 sT;
#pragma unroll
                for (int e = 0; e < 16; ++e) sT[e] = 0.f;
                LAS unsigned char* kp = KS + (32 * mt + r) * KSTR + 16 * hh;
                sT = lds_feed_mfma<16>(kp, qf, sT);
                if (mt == ct) {
#pragma unroll
                    for (int e = 0; e < 16; ++e) { const int kidx = 8 * (e >> 2) + 4 * hh + (e & 3); sT[e] = (kidx <= r) ? sT[e] : 0.f; }
                }
                const bf16x8 pf0 = pack8(sT[0], sT[1], sT[2], sT[3], sT[4], sT[5], sT[6], sT[7]), pf1 = pack8(sT[8], sT[9], sT[10], sT[11], sT[12], sT[13], sT[14], sT[15]);
                LAS unsigned char* vp = VT + (32 * et + r) * VSTR + (32 * mt + 4 * hh) * 2;
                const bf16x8 a0 = cat4(*(const LAS s16x4*)(vp), *(const LAS s16x4*)(vp + 16));
                const bf16x8 a1 = cat4(*(const LAS s16x4*)(vp + 32), *(const LAS s16x4*)(vp + 48));
                oacc = mfma32(a0, pf0, oacc);
                oacc = mfma32(a1, pf1, oacc);
            }
            {
                const int c = 32 * ct + r;
                const float sc = exp2f(lg2 * (float)(c + 1));
                float s1 = 0.f, s2 = 0.f;
                GAS bf16_t* op = oraw + (tok0 + c) * 2048 + h * 512 + es * 64 + 32 * et + 4 * hh;
#pragma unroll
                for (int i = 0; i < 4; ++i) {
                    const float v0 = oacc[4 * i] * sc, v1 = oacc[4 * i + 1] * sc, v2 = oacc[4 * i + 2] * sc, v3 = oacc[4 * i + 3] * sc;
                    s1 += (v0 + v1) + (v2 + v3); s2 += (v0 * v0 + v1 * v1) + (v2 * v2 + v3 * v3);
                    u32x2 wv; wv.x = cvt_pk_bf16(v0, v1); wv.y = cvt_pk_bf16(v2, v3);
                    *(GAS u32x2*)(op + 8 * i) = wv;
                }
                s1 += __shfl_xor(s1, 32); s2 += __shfl_xor(s2, 32);
                if (hh == 0) { f32x2 st; st.x = s1; st.y = s2; *(GAS f32x2*)(rst + (((tok0 + c) * 4 + h) * 16 + es * 2 + et) * 2) = st; }
            }
            if (n < 15) {
#pragma unroll
                for (int ks = 0; ks < 16; ++ks) qf[ks] = *(const GAS bf16x8*)(QF + ((((((size_t)(b * 4 + h) * 16 + (n + 1)) * 4 + ct) * 16 + ks) * 2 + hh) * 32 + r) * 8);
            }
            {
                LAS unsigned char* kp = KS + (8 * hh + tq) * KSTR + (32 * w + 16 * blk + 4 * tp) * 2;
                LAS unsigned char* vp = VT + r * VSTR + 16 * hh;
                s16x4 tl[2], th[2]; bf16x8 b0[2], b1[2];
                tl[0] = tr_read(kp); th[0] = tr_read(kp + 4 * KSTR); b0[0] = *(const LAS bf16x8*)(vp); b1[0] = *(const LAS bf16x8*)(vp + 32 * VSTR);
#pragma unroll
                for (int ms = 0; ms < 8; ++ms) {
                    if (ms < 7) { tl[(ms + 1) & 1] = tr_read(kp + (16 * (ms + 1)) * KSTR); th[(ms + 1) & 1] = tr_read(kp + (16 * (ms + 1) + 4) * KSTR);
                        b0[(ms + 1) & 1] = *(const LAS bf16x8*)(vp + 32 * (ms + 1)); b1[(ms + 1) & 1] = *(const LAS bf16x8*)(vp + 32 * VSTR + 32 * (ms + 1)); }
                    __builtin_amdgcn_sched_barrier(0);
                    const bf16x8 a = cat4(tl[ms & 1], th[ms & 1]);
                    __builtin_amdgcn_s_setprio(1);
                    Sacc[0] = mfma32(a, b0[ms & 1], Sacc[0]);
                    Sacc[1] = mfma32(a, b1[ms & 1], Sacc[1]);
                    __builtin_amdgcn_s_setprio(0);
                    __builtin_amdgcn_sched_barrier(0);
                }
                const float dc = exp2f(lg2 * 128.f);
#pragma unroll
                for (int e = 0; e < 16; ++e) { Sacc[0][e] *= dc; Sacc[1][e] *= dc; }
            }
            LDS_BARRIER();
#pragma unroll
            for (int e2 = 0; e2 < 2; ++e2)
#pragma unroll
                for (int i = 0; i < 4; ++i) {
                    u32x2 wv; wv.x = cvt_pk_bf16(Sacc[e2][4 * i], Sacc[e2][4 * i + 1]); wv.y = cvt_pk_bf16(Sacc[e2][4 * i + 2], Sacc[e2][4 * i + 3]);
                    *(LAS u32x2*)(ST + (32 * e2 + r) * KSTR + (32 * w + 8 * i + 4 * hh) * 2) = wv;
                }
        }
        LDS_BARRIER();
    }
}
__device__ __forceinline__ void ret_norm_phase(const GAS bf16_t* proj, GAS bf16_t* oraw, const GAS float* rst, int G, int cblk) {
    const int tid = opq_tid(), lane = tid & 63, wave = tid >> 6;
    for (int row = cblk * 8 + wave; row < TH; row += G * 8) {
        const f32x2 st = *(const GAS f32x2*)(rst + ((size_t)row * 64 + lane) * 2);
        u32x4 ov[4], gv[4];
#pragma unroll
        for (int h = 0; h < 4; ++h) { ov[h] = *(const GAS u32x4*)(oraw + (size_t)row * 2048 + h * 512 + lane * 8); gv[h] = *(const GAS u32x4*)(proj + (size_t)row * 6144 + 4096 + h * 512 + lane * 8); }
        float s1 = st.x, s2 = st.y;
#pragma unroll
        for (int o = 1; o < 16; o <<= 1) { s1 += __shfl_xor(s1, o); s2 += __shfl_xor(s2, o); }
#pragma unroll
        for (int h = 0; h < 4; ++h) {
            const float t1 = __shfl(s1, 16 * h), t2 = __shfl(s2, 16 * h);
            const float mu = t1 * (1.f / 512.f);
            const float var = __builtin_fmaxf(t2 * (1.f / 512.f) - mu * mu, 0.f);
            const float rstd = 1.f / sqrtf(var + EPS);
            const u32x4 o4 = ov[h], g4 = gv[h];
            u32x4 wv;
            wv.x = cvt_pk_bf16((bf_lo(o4.x) - mu) * rstd * bf_lo(g4.x), (bf_hi(o4.x) - mu) * rstd * bf_hi(g4.x));
            wv.y = cvt_pk_bf16((bf_lo(o4.y) - mu) * rstd * bf_lo(g4.y), (bf_hi(o4.y) - mu) * rstd * bf_hi(g4.y));
            wv.z = cvt_pk_bf16((bf_lo(o4.z) - mu) * rstd * bf_lo(g4.z), (bf_hi(o4.z) - mu) * rstd * bf_hi(g4.z));
            wv.w = cvt_pk_bf16((bf_lo(o4.w) - mu) * rstd * bf_lo(g4.w), (bf_hi(o4.w) - mu) * rstd * bf_hi(g4.w));
            *(GAS u32x4*)(oraw + (size_t)row * 2048 + h * 512 + lane * 8) = wv;
        }
    }
}

__device__ __forceinline__ void sgu_core_phase(const GAS bf16_t* z, const GAS float* ssv, const GAS float* w_s, const GAS float* b_s, const GAS float* gn, GAS bf16_t* umix, LAS unsigned char* lds, int G, int cblk) {
    const int tid = opq_tid(), lane = tid & 63, w = __builtin_amdgcn_readfirstlane(tid >> 6), r = lane & 31, hh = lane >> 5;
    const int blk = (lane >> 4) & 1, tq = (lane & 15) >> 2, tp = lane & 3;
    constexpr int VSTR = 528, WSTR = 272;
    LAS unsigned char* VI = lds; LAS unsigned char* WI = lds + 128 * VSTR; LAS float* RS = (LAS float*)(lds + 128 * VSTR + 128 * WSTR);
    u32x4 vpre[8];
    if (cblk < 1024) { const int g0 = cblk & 7; const size_t t00 = (size_t)(cblk >> 3) * 128;
#pragma unroll
        for (int i = 0; i < 8; ++i) { const int id = tid + 512 * i, row = id >> 5, pc = id & 31; vpre[i] = *(const GAS u32x4*)(z + (t00 + row) * 4096 + 2048 + g0 * 256 + pc * 8); } }
#pragma unroll 1
    for (int u = cblk; u < 1024; u += G) {
        const int g = u & 7, bn = u >> 3;
        const size_t t0 = (size_t)bn * 128;
        if (tid < 128) {
            const GAS f32x4* sp = (const GAS f32x4*)(ssv + (t0 + tid) * 32);
            f32x4 a = sp[0];
#pragma unroll
            for (int i = 1; i < 8; ++i) a += sp[i];
            RS[tid] = __builtin_amdgcn_rsqf(((a.x + a.y) + (a.z + a.w)) * (1.f / 2048.f) + EPS);
        }
#pragma unroll
        for (int i = 0; i < 8; ++i) { const int id = tid + 512 * i, row = id >> 5, pc = id & 31; *(LAS u32x4*)(VI + row * VSTR + pc * 16) = vpre[i]; }
        LDS_BARRIER();
#pragma unroll
        for (int i = 0; i < 4; ++i) { const int id = tid + 512 * i, t = id >> 4, pc = id & 15;
            const GAS float* wp = w_s + ((size_t)g * 128 + t) * 128 + pc * 8;
            const f32x4 a = *(const GAS f32x4*)wp, b2 = *(const GAS f32x4*)(wp + 4);
            float v[8];
#pragma unroll
            for (int e = 0; e < 4; ++e) { v[e] = a[e]; v[4 + e] = b2[e]; }
#pragma unroll
            for (int e = 0; e < 8; ++e) { const int s = pc * 8 + e; v[e] = (s <= t) ? v[e] * RS[s] : 0.f; }
            u32x4 wv; wv.x = cvt_pk_bf16(v[0], v[1]); wv.y = cvt_pk_bf16(v[2], v[3]); wv.z = cvt_pk_bf16(v[4], v[5]); wv.w = cvt_pk_bf16(v[6], v[7]);
            *(LAS u32x4*)(WI + t * WSTR + pc * 16) = wv; }
        LDS_BARRIER();
        f32x16 acc[4];
#pragma unroll
        for (int tt = 0; tt < 4; ++tt)
#pragma unroll
            for (int e = 0; e < 16; ++e) acc[tt][e] = 0.f;
        LAS unsigned char* vp = VI + (8 * hh + tq) * VSTR + (32 * w + 16 * blk + 4 * tp) * 2;
        LAS unsigned char* wp = WI + r * WSTR + 16 * hh;
        s16x4 tl[2], th[2]; bf16x8 wb[2][4];
        tl[0] = tr_read(vp); th[0] = tr_read(vp + 4 * VSTR);
#pragma unroll
        for (int tt = 0; tt < 4; ++tt) wb[0][tt] = *(const LAS bf16x8*)(wp + (32 * tt) * WSTR);
#pragma unroll
        for (int ks = 0; ks < 8; ++ks) {
            if (ks < 7) { tl[(ks + 1) & 1] = tr_read(vp + (16 * (ks + 1)) * VSTR); th[(ks + 1) & 1] = tr_read(vp + (16 * (ks + 1) + 4) * VSTR);
#pragma unroll
                for (int tt = 0; tt < 4; ++tt) if (ks + 1 <= 2 * tt + 1) wb[(ks + 1) & 1][tt] = *(const LAS bf16x8*)(wp + (32 * tt) * WSTR + 32 * (ks + 1)); }
            __builtin_amdgcn_sched_barrier(0);
            const bf16x8 a = cat4(tl[ks & 1], th[ks & 1]);
            __builtin_amdgcn_s_setprio(1);
#pragma unroll
            for (int tt = 0; tt < 4; ++tt)
                if (ks <= 2 * tt + 1) acc[tt] = mfma32(a, wb[ks & 1][tt], acc[tt]);
            __builtin_amdgcn_s_setprio(0);
            __builtin_amdgcn_sched_barrier(0);
        }
        f32x4 gvv[4]; u32x2 uqq[4][4]; float biasv[4];
#pragma unroll
        for (int i = 0; i < 4; ++i) gvv[i] = *(const GAS f32x4*)(gn + g * 256 + 32 * w + 8 * i + 4 * hh);
#pragma unroll
        for (int tt = 0; tt < 4; ++tt) {
            biasv[tt] = b_s[g * 128 + 32 * tt + r];
#pragma unroll
            for (int i = 0; i < 4; ++i) uqq[tt][i] = *(const GAS u32x2*)(z + (t0 + 32 * tt + r) * 4096 + g * 256 + 32 * w + 8 * i + 4 * hh);
        }
        if (u + G < 1024) { const int gn2 = (u + G) & 7; const size_t tn2 = (size_t)((u + G) >> 3) * 128;
#pragma unroll
            for (int i = 0; i < 8; ++i) { const int id = tid + 512 * i, row = id >> 5, pc = id & 31; vpre[i] = *(const GAS u32x4*)(z + (tn2 + row) * 4096 + 2048 + gn2 * 256 + pc * 8); } }
#pragma unroll
        for (int tt = 0; tt < 4; ++tt) {
            const int t = 32 * tt + r;
            const float bias = biasv[tt];
#pragma unroll
            for (int i = 0; i < 4; ++i) {
                const int c4 = g * 256 + 32 * w + 8 * i + 4 * hh;
                const f32x4 gv = gvv[i];
                const u32x2 uq = uqq[tt][i];
                const float o0 = bf_lo(uq.x) * (acc[tt][4 * i] * gv[0] + bias), o1 = bf_hi(uq.x) * (acc[tt][4 * i + 1] * gv[1] + bias);
                const float o2 = bf_lo(uq.y) * (acc[tt][4 * i + 2] * gv[2] + bias), o3 = bf_hi(uq.y) * (acc[tt][4 * i + 3] * gv[3] + bias);
                u32x2 wv; wv.x = cvt_pk_bf16(o0, o1); wv.y = cvt_pk_bf16(o2, o3);
                *(GAS u32x2*)(umix + (t0 + t) * 2048 + c4) = wv;
            }
        }
        LDS_BARRIER();
    }
}

#define XB_TMO      128
#define XB_XCNT(j)  (256  + 64 * (j))
#define XB_XSUB(j)  (1280 + 64 * (j))
#define XB_XGEN(j)  (2304 + 64 * (j))
#define XB_TOP      3328
#define XB_TOPGEN   3392
#define XCD_BAR_WORDS 3456
#define XB_SPIN_CAP (1u << 18)

__device__ __forceinline__ unsigned xb_ld(unsigned* p)              { return __hip_atomic_load(p, __ATOMIC_RELAXED, __HIP_MEMORY_SCOPE_AGENT); }
__device__ __forceinline__ unsigned xb_add(unsigned* p, unsigned v) { return __hip_atomic_fetch_add(p, v, __ATOMIC_RELAXED, __HIP_MEMORY_SCOPE_AGENT); }
__device__ __forceinline__ unsigned xb_xcc_id() { return (unsigned)__builtin_amdgcn_s_getreg((3 << 11) | 20) & 0xFu; }
#define XB_SPIN(cond, bar) do { unsigned _sp = 0; while (cond) { __builtin_amdgcn_s_sleep(1); \
    if ((++_sp & 255u) == 0u) { if (xb_ld(&(bar)[XB_TMO])) break; if (_sp > XB_SPIN_CAP) { atomicAdd(&(bar)[XB_TMO], 1u); break; } } } } while (0)

struct XcdBarrier {
    unsigned* bar; unsigned x;
    volatile LAS unsigned* st;
};

__device__ __forceinline__ XcdBarrier xcd_barrier_post(unsigned* bar, volatile LAS unsigned* st) {
    XcdBarrier b; b.bar = bar; b.x = xb_xcc_id(); b.st = st;
    if (opq_tid() == 0) (void)xb_add(&bar[XB_XCNT(b.x)], 1u);
    return b;
}
__device__ __forceinline__ void xcd_barrier_complete(unsigned* bar, unsigned x, unsigned& nloc, unsigned& nx) {
    const unsigned G = gridDim.x * gridDim.y * gridDim.z;
    unsigned sum, cnt, mine, sp = 0u;
    for (;;) {
        sum = 0u; cnt = 0u; mine = 0u;
#pragma unroll
        for (unsigned j = 0; j < 16; ++j) { const unsigned c = xb_ld(&bar[XB_XCNT(j)]); sum += c; cnt += (c > 0u) ? 1u : 0u; mine = (j == x) ? c : mine; }
        if (sum == G) break;
        __builtin_amdgcn_s_sleep(1);
        if ((++sp & 255u) == 0u) { if (xb_ld(&bar[XB_TMO])) break; if (sp > XB_SPIN_CAP) { atomicAdd(&bar[XB_TMO], 1u); break; } }
    }
    nloc = mine > 0u ? mine : 1u; nx = cnt > 0u ? cnt : 1u;
}

__device__ __forceinline__ void xcd_barrier(const XcdBarrier& b) {
    asm volatile("s_waitcnt vmcnt(0)" ::: "memory");
    __syncthreads();
    if (opq_tid() == 0) {
        unsigned* bar = b.bar;
        __builtin_amdgcn_s_waitcnt(0);
        unsigned nloc = b.st[0], nx = b.st[1];
        if (nloc == 0u) { xcd_barrier_complete(bar, b.x, nloc, nx); b.st[0] = nloc; b.st[1] = nx; }
        const unsigned old = xb_add(&bar[XB_XSUB(b.x)], 1u);
        const unsigned gen = old / nloc;
        if (old + 1u == (gen + 1u) * nloc) {
            __builtin_amdgcn_fence(__ATOMIC_RELEASE, "agent");
            asm volatile("s_waitcnt vmcnt(0)" ::: "memory");
            const unsigned og = xb_add(&bar[XB_TOP], 1u);
            const unsigned tg = og / nx;
            if (og + 1u == (tg + 1u) * nx) xb_add(&bar[XB_TOPGEN], 1u);
            else XB_SPIN(xb_ld(&bar[XB_TOPGEN]) == tg, bar);
            __builtin_amdgcn_fence(__ATOMIC_ACQUIRE, "agent");
            xb_add(&bar[XB_XGEN(b.x)], 1u);
            asm volatile("s_waitcnt vmcnt(0)" ::: "memory");
        } else {
            XB_SPIN(xb_ld(&bar[XB_XGEN(b.x)]) == gen, bar);
            __builtin_amdgcn_fence(__ATOMIC_ACQUIRE, "agent");
            asm volatile("s_waitcnt vmcnt(0)" ::: "memory");
        }
    }
    __syncthreads();
}


#define WSP(T, off) ((GAS T*)(opq_ptr(P.ws) + (off)))
#define GP(T, p) ((GAS T*)(p))
__global__ void __launch_bounds__(512, 2) mega_fwd(Params P) {
    extern __shared__ __attribute__((aligned(16))) unsigned char lds_raw[];
    LAS unsigned char* lds = (LAS unsigned char*)lds_raw;
    cg::grid_group grid = cg::this_grid();
    { const int t0 = opq_tid();
      if (blockIdx.x == 0) { unsigned* bw = (unsigned*)P.ws; for (int i = t0; i < XCD_BAR_WORDS; i += 512) bw[i] = 0u; }
      if (t0 < 64) ((LAS unsigned*)(lds + 131072))[t0] = 0u; }
    __syncthreads();

    prep_phase(P, lds, opq_s(gridDim.x), opq_s(blockIdx.x));
#pragma unroll 1
    for (int hb = 0; hb < 2; ++hb) {
        int sb = 0, xsel = 0;
        {
            const int G = opq_s(gridDim.x), cb = opq_s(blockIdx.x);
            load_half_phase(GP(const float, P.x) + (size_t)hb * TH * D, WSP(bf16_t, OFF_XB), WSP(float, OFF_SSP0), G, cb);
        }
        __syncthreads();
        if (hb == 0) { __threadfence(); grid.sync(); (void)xcd_barrier_post((unsigned*)P.ws, (volatile LAS unsigned*)(lds + 131072)); }
        else { XcdBarrier bar; bar.bar = (unsigned*)opq_ptr(P.ws); bar.x = xb_xcc_id(); bar.st = (volatile LAS unsigned*)(lds + 131072); xcd_barrier(bar); }
#pragma unroll 1
        for (int step = 0; step < DEPTH * 8; ++step) {
            const int li = step >> 3, ph = step & 7;
            const int kind = li % 3, j = li / 3;
            if ((ph == 2 && kind != 1) || ph == 5) continue;
            const int G = opq_s(gridDim.x), cb = opq_s(blockIdx.x);
            GAS bf16_t* XBc = xsel ? (GAS bf16_t*)opq_ptr(P.out + (size_t)hb * TH * D) : WSP(bf16_t, OFF_XB);
            if (ph == 0) {
                pconv_phase(GP(const float, P.p) + ((size_t)li * TFULL + (size_t)hb * TH) * PLD, WSP(bf16_t, OFF_PB), G, cb);
                const GAS float* ssi = WSP(const float, sb ? OFF_SSP1 : OFF_SSP0);
                if (kind == 0) {
                    pg8::Gemm g{XBc, WSP(const bf16_t, OFF_W) + W_SB_IN + (size_t)j * 3145728, TH, 3072, D}; pg8::StaticOrder S; S.init(TH, 3072, G, cb);
                    EpiBf16Scale E{WSP(bf16_t, OFF_BIG1), 3072, ssi};
                    pg8::gemm_phase(lds, g, S, E);
                } else if (kind == 1) {
                    pg8::Gemm g{XBc, WSP(const bf16_t, OFF_W) + W_RET_IN, TH, 6144, D}; pg8::StaticOrder S; S.init(TH, 6144, G, cb);
                    EpiRetIn E{WSP(bf16_t, OFF_BIG1), ssi, WSP(const float, OFF_COS), WSP(const float, OFF_SIN), WSP(bf16_t, OFF_QF)};
                    pg8::gemm_phase(lds, g, S, E);
                } else {
                    pg8::Gemm g{XBc, WSP(const bf16_t, OFF_W) + W_SGU_IN, TH, 4096, D}; pg8::StaticOrder S; S.init(TH, 4096, G, cb);
                    EpiSguIn E{WSP(bf16_t, OFF_BIG1), ssi, WSP(float, OFF_SSV)};
                    pg8::gemm_phase(lds, g, S, E);
                }
            } else if (ph == 1) {
                if (kind == 0) sb_attn_phase(WSP(const bf16_t, OFF_BIG1), WSP(bf16_t, OFF_BIG2), lds, G, cb);
                else if (kind == 1) ret_core_phase(WSP(const bf16_t, OFF_BIG1), WSP(const bf16_t, OFF_QF), WSP(bf16_t, OFF_BIG2), WSP(float, OFF_RST), lds, G, cb);
                else sgu_core_phase(WSP(const bf16_t, OFF_BIG1), WSP(const float, OFF_SSV), GP(const float, P.sgu_w_s), GP(const float, P.sgu_b_s), GP(const float, P.sgu_norm), WSP(bf16_t, OFF_BIG2), lds, G, cb);
            } else if (ph == 2) {
                ret_norm_phase(WSP(const bf16_t, OFF_BIG1), WSP(bf16_t, OFF_BIG2), WSP(const float, OFF_RST), G, cb);
            } else if (ph == 3) {
                {
                    const GAS bf16_t* Wb = WSP(const bf16_t, OFF_W);
                    const GAS bf16_t* Wo = (kind == 0) ? Wb + W_SB_OUT + (size_t)j * 1048576 : (kind == 1) ? Wb + W_RET_OUT : Wb + W_SGU_OUT;
                    const int Ko = (kind == 0) ? 1024 : 2048;
                    pg8::Gemm g{WSP(const bf16_t, OFF_BIG2), Wo, TH, D, Ko}; pg8::StaticOrder S; S.init(TH, D, G, cb);
                    EpiRes E{XBc, WSP(float, sb ? OFF_SSP0 : OFF_SSP1)};
                    pg8::gemm_phase(lds, g, S, E);
                    sb ^= 1;
                }
            } else if (ph == 4) {
                pg8::Gemm g{XBc, WSP(const bf16_t, OFF_W) + W_FFN_IN + (size_t)li * 5767168, TH, 2 * FFN, D}; pg8::StaticOrder S; S.init(TH, 2 * FFN, G, cb);
                EpiFfnConv E{WSP(bf16_t, OFF_BIG2), WSP(const float, sb ? OFF_SSP1 : OFF_SSP0), GP(const float, P.conv_w) + (size_t)li * 3 * FFN, GP(const float, P.conv_b) + (size_t)li * FFN, WSP(float, OFF_BIG1), WSP(float, OFF_BIG1 + 16 * MiB)};
                pg8::gemm_phase(lds, g, S, E);
                {
                    const int nun = (TH / 256) * (2 * FFN / 256), extra = nun % G;
                    const int Gp = extra ? G - extra : G, cp = extra ? cb - extra : cb;
                    if (cp >= 0) {
                        pg8::Gemm g2{WSP(const bf16_t, OFF_PB), WSP(const bf16_t, OFF_W) + W_PL_PROJ + (size_t)li * 262144, TH, D, PLD}; pg8::StaticOrder S2; S2.init(TH, D, Gp, cp);
                        EpiBf16Scale E2{WSP(bf16_t, OFF_PP), D, nullptr};
                        pg8::gemm_phase(lds, g2, S2, E2);
                    }
                }
            } else if (ph == 6) {
                pg8::Gemm g{WSP(const bf16_t, OFF_BIG2), WSP(const bf16_t, OFF_W) + W_FFN_OUT + (size_t)li * 2883584, TH, D, FFN}; pg8::StaticOrder S; S.init(TH, D, G, cb);
                { pg8::Unit fu; for (int i = 0; S.next(i, fu); ++i) ffn_fixup(WSP(bf16_t, OFF_BIG2), WSP(const float, OFF_BIG1), WSP(const float, OFF_BIG1 + 16 * MiB), GP(const float, P.conv_w) + (size_t)li * 3 * FFN, GP(const float, P.conv_b) + (size_t)li * FFN, fu.pm);
                  asm volatile("s_waitcnt vmcnt(0)" ::: "memory"); __syncthreads(); }
                EpiRes E{XBc, WSP(float, sb ? OFF_SSP0 : OFF_SSP1)};
                pg8::gemm_phase(lds, g, S, E);
                sb ^= 1;
            } else {
                pg8::Gemm g{XBc, WSP(const bf16_t, OFF_W) + W_PL_GATE + (size_t)li * 1048576, TH, D, D}; pg8::StaticOrder S; S.init(TH, D, G, cb);
                GAS bf16_t* XBn = xsel ? WSP(bf16_t, OFF_XB) : (GAS bf16_t*)opq_ptr(P.out + (size_t)hb * TH * D);
                EpiPL E{XBc, XBn, WSP(const float, sb ? OFF_SSP1 : OFF_SSP0), WSP(float, sb ? OFF_SSP0 : OFF_SSP1), WSP(const bf16_t, OFF_PP)};
                pg8::gemm_phase(lds, g, S, E);
                sb ^= 1; xsel ^= 1;
            }
            { XcdBarrier bar; bar.bar = (unsigned*)opq_ptr(P.ws); bar.x = xb_xcc_id(); bar.st = (volatile LAS unsigned*)(lds + 131072); xcd_barrier(bar); }
        }
        final_phase(WSP(const bf16_t, OFF_XB), GP(float, P.out) + (size_t)hb * TH * D, GP(const float, P.norm_final), opq_s(gridDim.x), opq_s(blockIdx.x));
        if (hb == 0) { XcdBarrier bar; bar.bar = (unsigned*)opq_ptr(P.ws); bar.x = xb_xcc_id(); bar.st = (volatile LAS unsigned*)(lds + 131072); xcd_barrier(bar); }
    }
}

extern "C" void kernel_launch(void* const* d_in, const int* in_sizes, int n_in, void* d_out, int out_size, void* d_ws, size_t ws_size, hipStream_t stream) {
    static int grid = 0;
    if (grid == 0) {
        if (n_in != 21 || ws_size < WS_NEED) { fprintf(stderr, "kernel_launch: unexpected n_in %d / ws %zu (need %zu)\n", n_in, ws_size, (size_t)WS_NEED); grid = -1; return; }
        int dev = 0, cus = 0, per_cu = 0;
        hipGetDevice(&dev);
        hipDeviceGetAttribute(&cus, hipDeviceAttributeMultiprocessorCount, dev);
        hipFuncSetAttribute((const void*)mega_fwd, hipFuncAttributeMaxDynamicSharedMemorySize, LDS_BYTES);
        hipOccupancyMaxActiveBlocksPerMultiprocessor(&per_cu, (const void*)mega_fwd, 512, LDS_BYTES);
        if (per_cu < 1) { fprintf(stderr, "kernel_launch: occupancy query says %d blocks/CU\n", per_cu); per_cu = 1; }
        grid = cus * 1;
        if (grid < 192) { fprintf(stderr, "kernel_launch: %d CUs: this build needs >= 192 (8 GEMM units per workgroup per phase at most)\n", grid); grid = -1; return; }
        (void)hipGetLastError();
    }
    if (grid < 0) return;
    Params P{};
    const float* const* in = (const float* const*)d_in;
    P.x = in[0]; P.p = in[1]; P.norm_final = in[5]; P.sgu_norm = in[11]; P.sgu_w_s = in[12]; P.sgu_b_s = in[13];
    P.conv_w = in[16]; P.conv_b = in[17]; P.out = (float*)d_out; P.ws = (unsigned char*)d_ws;
    const float* norm_mix = in[2]; const float* norm_ffn = in[3]; const float* norm_pl = in[4];
    bf16_t* Wb = (bf16_t*)((unsigned char*)d_ws + OFF_W);
    int mi = 0;
    auto add = [&](const float* W, const float* gain, size_t dst, int K, int N, int perm = 0) { P.mats[mi].W = W; P.mats[mi].gain = gain; P.mats[mi].dst = Wb + dst; P.mats[mi].K = K; P.mats[mi].N = N; P.mats[mi].perm = perm; P.mats[mi].pad = 0; ++mi; };
    for (int j = 0; j < 2; ++j) add(in[6] + (size_t)j * 1024 * 3072, norm_mix + (size_t)(3 * j) * 1024, W_SB_IN + (size_t)j * 3145728, 1024, 3072);
    for (int j = 0; j < 2; ++j) add(in[7] + (size_t)j * 1024 * 1024, nullptr, W_SB_OUT + (size_t)j * 1048576, 1024, 1024);
    add(in[8], norm_mix + 1 * 1024, W_RET_IN, 1024, 6144);
    add(in[9], nullptr, W_RET_OUT, 2048, 1024);
    add(in[10], norm_mix + 2 * 1024, W_SGU_IN, 1024, 4096);
    add(in[14], nullptr, W_SGU_OUT, 2048, 1024);
    for (int i = 0; i < 4; ++i) add(in[15] + (size_t)i * 1024 * 5632, norm_ffn + (size_t)i * 1024, W_FFN_IN + (size_t)i * 5767168, 1024, 5632, 1);
    for (int i = 0; i < 4; ++i) add(in[18] + (size_t)i * 2816 * 1024, nullptr, W_FFN_OUT + (size_t)i * 2883584, 2816, 1024);
    for (int i = 0; i < 4; ++i) add(in[19] + (size_t)i * 1024 * 1024, norm_pl + (size_t)i * 1024, W_PL_GATE + (size_t)i * 1048576, 1024, 1024);
    for (int i = 0; i < 4; ++i) add(in[20] + (size_t)i * 256 * 1024, nullptr, W_PL_PROJ + (size_t)i * 262144, 256, 1024);
    void* args[] = {&P};
    hipError_t e = hipLaunchCooperativeKernel((const void*)mega_fwd, dim3(grid), dim3(512), args, LDS_BYTES, stream);
    if (e != hipSuccess) fprintf(stderr, "kernel_launch: cooperative launch failed: %s (grid %d)\n", hipGetErrorString(e), grid);
}
```

```cpp
#include <hip/hip_runtime.h>
#include <hip/hip_cooperative_groups.h>
#include <cstdio>
#include <cstdint>
namespace cg = cooperative_groups;

#define LAS __attribute__((address_space(3)))
#define GAS __attribute__((address_space(1)))
typedef unsigned short bf16_t;
typedef short bf16x8 __attribute__((ext_vector_type(8)));
typedef short s16x4 __attribute__((ext_vector_type(4)));
typedef float f32x4 __attribute__((ext_vector_type(4)));
typedef float f32x2 __attribute__((ext_vector_type(2)));
typedef float f32x16 __attribute__((ext_vector_type(16)));
typedef unsigned u32x4 __attribute__((ext_vector_type(4)));
typedef unsigned u32x2 __attribute__((ext_vector_type(2)));

constexpr int D = 1024, SEQ = 2048, DEPTH = 4, FFN = 2816, PLD = 256;
constexpr int TH = 16384;
constexpr int TFULL = 32768;
constexpr float EPS = 1e-6f;
constexpr float LOG2E = 1.4426950408889634f;

constexpr size_t W_SB_IN = 0, W_SB_OUT = 6291456, W_RET_IN = 8388608, W_RET_OUT = 14680064, W_SGU_IN = 16777216, W_SGU_OUT = 20971520,
                 W_FFN_IN = 23068672, W_FFN_OUT = 46137344, W_PL_GATE = 57671680, W_PL_PROJ = 61865984, W_END = 62914560;
constexpr size_t MiB = 1u << 20;
constexpr size_t OFF_COS = 1 * MiB, OFF_SIN = 2 * MiB, OFF_W = 3 * MiB, OFF_XB = 123 * MiB, OFF_PB = 155 * MiB, OFF_PP = 163 * MiB,
                 OFF_SSP0 = 195 * MiB, OFF_SSP1 = 196 * MiB, OFF_SSV = 197 * MiB, OFF_RST = 199 * MiB, OFF_BIG1 = 207 * MiB, OFF_BIG2 = 399 * MiB, OFF_QF = 463 * MiB  , WS_NEED = 495 * MiB;
constexpr int LDS_BYTES = 135168;
constexpr int LDS_RSL = 131072 + 512;

struct MatDesc { const float* W; const float* gain; bf16_t* dst; int K, N, perm, pad; };
struct Params {
    const float* x; const float* p; const float* norm_final; const float* sgu_norm; const float* sgu_w_s; const float* sgu_b_s;
    const float* conv_w; const float* conv_b; float* out; unsigned char* ws;
    MatDesc mats[24];
};

#define LDS_BARRIER() do { asm volatile("s_waitcnt lgkmcnt(0)" ::: "memory"); __builtin_amdgcn_s_barrier(); asm volatile("" ::: "memory"); } while (0)
__device__ __forceinline__ int opq_tid() { int t = threadIdx.x; asm volatile("" : "+v"(t)); return t; }
template <class T> __device__ __forceinline__ T* opq_ptr(T* p) { asm volatile("" : "+s"(p)); return p; }
__device__ __forceinline__ int opq_s(int v) { asm volatile("" : "+s"(v)); return v; }
__device__ __forceinline__ unsigned cvt_pk_bf16(float lo, float hi) { unsigned r; asm volatile("v_cvt_pk_bf16_f32 %0, %1, %2" : "=v"(r) : "v"(lo), "v"(hi)); return r; }
__device__ __forceinline__ float bf_lo(unsigned w) { return __uint_as_float(w << 16); }
__device__ __forceinline__ float bf_hi(unsigned w) { return __uint_as_float(w & 0xffff0000u); }
__device__ __forceinline__ float wave_sum(float v) {
#pragma unroll
    for (int o = 1; o < 64; o <<= 1) v += __shfl_xor(v, o);
    return v;
}
__device__ __forceinline__ float fast_sigmoid(float g) { return __builtin_amdgcn_rcpf(1.f + __builtin_amdgcn_exp2f(-g * LOG2E)); }
__device__ __forceinline__ float gelu_tanh(float x) { const float u = 0.7978845608028654f * (x + 0.044715f * x * x * x); return x * fast_sigmoid(2.f * u); }
__device__ __forceinline__ f32x16 mfma32(bf16x8 a, bf16x8 b, f32x16 c) { return __builtin_amdgcn_mfma_f32_32x32x16_bf16(a, b, c, 0, 0, 0); }
__device__ __forceinline__ s16x4 tr_read(LAS unsigned char* p) {
    typedef short v4i16_t __attribute__((ext_vector_type(4)));
    return __builtin_bit_cast(s16x4, __builtin_amdgcn_ds_read_tr16_b64_v4i16((LAS v4i16_t*)p));
}
__device__ __forceinline__ bf16x8 cat4(s16x4 lo, s16x4 hi) { bf16x8 r; r[0] = lo[0]; r[1] = lo[1]; r[2] = lo[2]; r[3] = lo[3]; r[4] = hi[0]; r[5] = hi[1]; r[6] = hi[2]; r[7] = hi[3]; return r; }
__device__ __forceinline__ bf16x8 pack8(float a0, float a1, float a2, float a3, float a4, float a5, float a6, float a7) {
    u32x4 w; w.x = cvt_pk_bf16(a0, a1); w.y = cvt_pk_bf16(a2, a3); w.z = cvt_pk_bf16(a4, a5); w.w = cvt_pk_bf16(a6, a7); return __builtin_bit_cast(bf16x8, w);
}
__device__ __forceinline__ float rs_from_ssp(const GAS float* ssp, int row) {
    const GAS f32x4* p = (const GAS f32x4*)(ssp + (size_t)row * 16);
    const f32x4 a = p[0], b = p[1], c = p[2], d = p[3];
    const f32x4 s = (a + b) + (c + d);
    return __builtin_amdgcn_rsqf(((s.x + s.y) + (s.z + s.w)) * (1.f / 1024.f) + EPS);
}

__device__ __forceinline__ LAS float* rs_table() { __shared__ __attribute__((aligned(16))) float rs_tab[8 * 256]; return (LAS float*)rs_tab; }
namespace pg8 {
constexpr int BM = 256, BK = 64, HALF = 128, HTB = HALF * BK * 2, STAGE_BYTES = 8 * HTB, NXCD = 8, WGM = 4;
__host__ __device__ __forceinline__ int lds_byte(int r, int c) { const int st = (r >> 4) * 2 + (c >> 5), rr = r & 15, cc = c & 31, ob = rr * 64 + cc * 2; return st * 1024 + (ob ^ (((ob >> 9) & 1) << 5)); }
__host__ __device__ __forceinline__ void stage_rc(int b, int& R, int& C) { const int st = b / 1024, sb = b % 1024, swz = sb ^ (((sb >> 9) & 1) << 5); R = (st >> 1) * 16 + swz / 64; C = (st & 1) * 32 + (swz % 64) / 2; }
__host__ __device__ __forceinline__ int perm32(int rho) { const int n = rho >> 4, i = rho & 15; return 8 * (i >> 2) + 4 * n + (i & 3); }
struct Unit { int pm, pn; };
struct Gemm { const GAS bf16_t* A; const GAS bf16_t* Bt; int M, N, K; };
struct StaticOrder {
    int nM, nN, nwg, G, c;
    __host__ __device__ void init(int M, int N, int G_, int c_) { nM = M / BM; nN = N / BM; nwg = nM * nN; G = G_; c = c_; }
    __host__ __device__ bool next(int i, Unit& u) const {
        const long L = (long)i * G + c; if (L >= nwg) return false;
        int wgid = (int)L; { const int q = nwg / NXCD, r = nwg % NXCD, xcd = wgid % NXCD, off = wgid / NXCD; wgid = (xcd < r ? xcd * (q + 1) : r * (q + 1) + (xcd - r) * q) + off; }
        const int nig = WGM * nN, gid = wgid / nig, fm = gid * WGM, gsz = (nM - fm) < WGM ? (nM - fm) : WGM;
        u.pm = fm + ((wgid % nig) % gsz); u.pn = (wgid % nig) / gsz; return true;
    }
};
template <class Epi>
__device__ __forceinline__ void gemm_phase(LAS unsigned char* lds, const Gemm g, const StaticOrder& S, const Epi& E) {
    const int tid = opq_tid(), wid = __builtin_amdgcn_readfirstlane(tid >> 6), lane = tid & 63, wr = wid >> 2, wc = wid & 3, fr = lane & 15, fq = lane >> 4;
    LAS float* rsl = rs_table();
    if constexpr (Epi::USES_RS) { if (E.rs_src()) {
        const int hi = __builtin_amdgcn_readfirstlane(tid >> 8), rw = tid & 255;
        Unit u0; (void)S.next(0, u0);
#pragma unroll
        for (int j = 0; j < 4; ++j) { Unit uu; const int pmj = S.next(2 * j + hi, uu) ? uu.pm : u0.pm;
            rsl[(2 * j + hi) * 256 + rw] = rs_from_ssp(E.rs_src(), pmj * 256 + rw); } } }
    const int K = g.K, nt = K / BK;
    unsigned voffA[2], voffB[2];
#pragma unroll
    for (int i = 0; i < 2; ++i) { int R, C; stage_rc(tid * 16 + i * 8192, R, C); const int Rb = Epi::PERM ? ((R & ~31) + perm32(R & 31)) : R;
        voffA[i] = (unsigned)(R * K + C) * 2u; voffB[i] = (unsigned)(Rb * K + C) * 2u; }
    const size_t kstep = (size_t)(BK * 2);
    const size_t hstep = (size_t)HALF * K * 2;
    const size_t tstep = 2 * hstep;
    const unsigned ldsw = (unsigned)wid * 1024u;
    const int aoff = lds_byte(wr * 64 + fr, fq * 8), boff = lds_byte(wc * 32 + fr, fq * 8);
#define PG8_SA(b, h) (((b) * 2 + (h)) * HTB)
#define PG8_SB(b, h) ((4 + (b) * 2 + (h)) * HTB)
#define PG8_STAGE(bufoff, gbase, voff) do { _Pragma("unroll") for (int _i = 0; _i < 2; ++_i) \
        __builtin_amdgcn_global_load_lds((const GAS unsigned*)((const GAS char*)(gbase) + (voff)[_i]), (LAS unsigned*)(lds + (bufoff) + ldsw + _i * 8192), 16, 0, 0); } while (0)
#define PG8_LDA(dst, b, h) do { _Pragma("unroll") for (int m = 0; m < 4; ++m) _Pragma("unroll") for (int k = 0; k < 2; ++k) dst[m][k] = *(const LAS bf16x8*)(lds + PG8_SA(b, h) + aoff + m * 2048 + k * 1024); } while (0)
#define PG8_LDB(dst, b, h) do { _Pragma("unroll") for (int n = 0; n < 2; ++n) _Pragma("unroll") for (int k = 0; k < 2; ++k) dst[n][k] = *(const LAS bf16x8*)(lds + PG8_SB(b, h) + boff + n * 2048 + k * 1024); } while (0)
#define PG8_MMA(ai, bj, At, Bt) do { __builtin_amdgcn_s_setprio(1); _Pragma("unroll") for (int m = 0; m < 4; ++m) _Pragma("unroll") for (int n = 0; n < 2; ++n) _Pragma("unroll") for (int k = 0; k < 2; ++k) \
        acc[ai][bj][m][n] = __builtin_amdgcn_mfma_f32_16x16x32_bf16(Bt[n][k], At[m][k], acc[ai][bj][m][n], 0, 0, 0); __builtin_amdgcn_s_setprio(0); } while (0)
#define PG8_WAIT_V(n) asm volatile("s_waitcnt vmcnt(" #n ")" ::: "memory")
#define PG8_WAIT_L(n) asm volatile("s_waitcnt lgkmcnt(" #n ")" ::: "memory")
#define PG8_BAR __builtin_amdgcn_s_barrier()
#define PG8_SCHED __builtin_amdgcn_sched_barrier(0)
    Unit cur, nxt; int ui = 0;
    if (!S.next(0, cur)) return;
    f32x4 acc[2][2][4][2];
    if constexpr (Epi::HAS_INIT) E.init(acc, cur, wr, wc, fr, fq);
    else {
#pragma unroll
    for (int a = 0; a < 2; ++a)
#pragma unroll
        for (int b = 0; b < 2; ++b)
#pragma unroll
            for (int m = 0; m < 4; ++m)
#pragma unroll
                for (int n = 0; n < 2; ++n) acc[a][b][m][n] = (f32x4){0.f, 0.f, 0.f, 0.f};
    }
    bf16x8 At[4][2], B0[2][2], B1[2][2];
    const GAS char* cA = (const GAS char*)g.A + (size_t)cur.pm * tstep; const GAS char* cB = (const GAS char*)g.Bt + (size_t)cur.pn * tstep;
    PG8_STAGE(PG8_SB(0, 0), cB, voffB); PG8_STAGE(PG8_SB(0, 1), cB + hstep, voffB); PG8_STAGE(PG8_SA(0, 0), cA, voffA); PG8_STAGE(PG8_SA(0, 1), cA + hstep, voffA);
    if (wr == 1) PG8_BAR;
    PG8_WAIT_V(2); PG8_BAR;
    PG8_STAGE(PG8_SB(1, 0), cB + kstep, voffB); PG8_STAGE(PG8_SA(1, 0), cA + kstep, voffA); PG8_STAGE(PG8_SB(1, 1), cB + hstep + kstep, voffB);
    PG8_WAIT_V(6); PG8_BAR;
    for (;;) {
        const bool has_next = S.next(ui + 1, nxt);
        const GAS char* nA = has_next ? (const GAS char*)g.A + (size_t)nxt.pm * tstep : cA; const GAS char* nB = has_next ? (const GAS char*)g.Bt + (size_t)nxt.pn * tstep : cB;
        for (int t = 0; t < nt; t += 2) {
            const bool last = (t == nt - 2);
            const GAS char* a1 = cA + (size_t)(t + 1) * kstep;
            const GAS char* a2 = last ? nA : cA + (size_t)(t + 2) * kstep; const GAS char* b2 = last ? nB : cB + (size_t)(t + 2) * kstep;
            const GAS char* a3 = a2 + kstep; const GAS char* b3 = b2 + kstep;
            PG8_LDB(B0, 0, 0); PG8_LDB(B1, 0, 1); PG8_SCHED; PG8_LDA(At, 0, 0); PG8_STAGE(PG8_SA(1, 1), a1 + hstep, voffA);
            PG8_WAIT_V(8); PG8_WAIT_L(0); PG8_BAR; PG8_MMA(0, 0, At, B0); PG8_MMA(0, 1, At, B1); PG8_BAR; PG8_SCHED;
            PG8_LDA(At, 0, 1); PG8_STAGE(PG8_SB(0, 0), b2, voffB); PG8_STAGE(PG8_SB(0, 1), b2 + hstep, voffB); PG8_STAGE(PG8_SA(0, 0), a2, voffA);
            PG8_WAIT_V(8); PG8_WAIT_L(0); PG8_BAR; PG8_MMA(1, 0, At, B0); PG8_MMA(1, 1, At, B1); PG8_BAR; PG8_SCHED;
            PG8_LDB(B0, 1, 0); PG8_LDB(B1, 1, 1); PG8_SCHED; PG8_LDA(At, 1, 0); PG8_STAGE(PG8_SA(0, 1), a2 + hstep, voffA);
            PG8_WAIT_V(8); PG8_WAIT_L(0); PG8_BAR; PG8_MMA(0, 0, At, B0); PG8_MMA(0, 1, At, B1); PG8_BAR; PG8_SCHED;
            PG8_LDA(At, 1, 1); PG8_STAGE(PG8_SB(1, 0), b3, voffB); PG8_STAGE(PG8_SB(1, 1), b3 + hstep, voffB); PG8_STAGE(PG8_SA(1, 0), a3, voffA);
            PG8_WAIT_V(8); PG8_WAIT_L(0); PG8_BAR; PG8_MMA(1, 0, At, B0); PG8_MMA(1, 1, At, B1); PG8_BAR; PG8_SCHED;
        }
        if (wr == 0) PG8_BAR;
        E(acc, cur, wr, wc, fr, fq, rsl + (ui & 7) * 256);
        if (!has_next) break;
        if constexpr (Epi::HAS_INIT) E.init(acc, nxt, wr, wc, fr, fq);
        else {
#pragma unroll
        for (int a = 0; a < 2; ++a)
#pragma unroll
            for (int b = 0; b < 2; ++b)
#pragma unroll
                for (int m = 0; m < 4; ++m)
#pragma unroll
                    for (int n = 0; n < 2; ++n) acc[a][b][m][n] = (f32x4){0.f, 0.f, 0.f, 0.f};
        }
        cur = nxt; cA = nA; cB = nB; ++ui;
        if (wr == 1) PG8_BAR;
    }
    PG8_WAIT_V(0);
    PG8_BAR;
#undef PG8_SA
#undef PG8_SB
#undef PG8_STAGE
#undef PG8_LDA
#undef PG8_LDB
#undef PG8_MMA
#undef PG8_WAIT_V
#undef PG8_WAIT_L
#undef PG8_BAR
#undef PG8_SCHED
}
}
using pg8::Unit;
typedef const f32x4 (&AccRef)[2][2][4][2];

struct EpiBf16Scale {
    static constexpr bool PERM = true, HAS_INIT = false, USES_RS = true;
    GAS bf16_t* O; int ldc; const GAS float* ssp;
    __device__ __forceinline__ const GAS float* rs_src() const { return ssp; }
    __device__ __forceinline__ void operator()(AccRef acc, const Unit& u, int wr, int wc, int fr, int fq, const LAS float* rsl) const {
        const int row0 = u.pm * 256 + wr * 64 + fr, col0 = u.pn * 256 + wc * 32 + 8 * fq;
#pragma unroll
        for (int ai = 0; ai < 2; ++ai)
#pragma unroll
            for (int m = 0; m < 4; ++m) {
                const int row = row0 + ai * 128 + m * 16;
                const float rs = ssp ? rsl[ai * 128 + wr * 64 + m * 16 + fr] : 1.f;
                GAS bf16_t* rowp = O + (size_t)row * ldc + col0;
#pragma unroll
                for (int bj = 0; bj < 2; ++bj) {
                    const f32x4 v0 = acc[ai][bj][m][0] * rs, v1 = acc[ai][bj][m][1] * rs;
                    u32x4 w; w.x = cvt_pk_bf16(v0[0], v0[1]); w.y = cvt_pk_bf16(v0[2], v0[3]); w.z = cvt_pk_bf16(v1[0], v1[1]); w.w = cvt_pk_bf16(v1[2], v1[3]);
                    *(GAS u32x4*)(rowp + bj * 128) = w;
                }
            }
    }
};
__device__ __forceinline__ float sq8(const u32x4 w) {
    const float a0 = bf_lo(w.x), a1 = bf_hi(w.x), a2 = bf_lo(w.y), a3 = bf_hi(w.y), a4 = bf_lo(w.z), a5 = bf_hi(w.z), a6 = bf_lo(w.w), a7 = bf_hi(w.w);
    return ((a0 * a0 + a1 * a1) + (a2 * a2 + a3 * a3)) + ((a4 * a4 + a5 * a5) + (a6 * a6 + a7 * a7));
}
struct EpiRes {
    static constexpr bool PERM = true, HAS_INIT = true, USES_RS = false;
    GAS bf16_t* XB; GAS float* sso;
    __device__ __forceinline__ const GAS float* rs_src() const { return nullptr; }
    __device__ __forceinline__ void init(f32x4 (&acc)[2][2][4][2], const Unit& u, int wr, int wc, int fr, int fq) const {
        const int row0 = u.pm * 256 + wr * 64 + fr, col0 = u.pn * 256 + wc * 32 + 8 * fq;
#pragma unroll
        for (int ai = 0; ai < 2; ++ai)
#pragma unroll
            for (int m = 0; m < 4; ++m)
#pragma unroll
                for (int bj = 0; bj < 2; ++bj) {
                    const u32x4 xw = *(const GAS u32x4*)(XB + (size_t)(row0 + ai * 128 + m * 16) * D + col0 + bj * 128);
                    acc[ai][bj][m][0] = (f32x4){bf_lo(xw.x), bf_hi(xw.x), bf_lo(xw.y), bf_hi(xw.y)};
                    acc[ai][bj][m][1] = (f32x4){bf_lo(xw.z), bf_hi(xw.z), bf_lo(xw.w), bf_hi(xw.w)};
                }
    }
    __device__ __forceinline__ void operator()(AccRef acc, const Unit& u, int wr, int wc, int fr, int fq, const LAS float* rsl) const {
        const int row0 = u.pm * 256 + wr * 64 + fr, col0 = u.pn * 256 + wc * 32 + 8 * fq;
#pragma unroll
        for (int ai = 0; ai < 2; ++ai)
#pragma unroll
            for (int m = 0; m < 4; ++m) {
                const int row = row0 + ai * 128 + m * 16;
                float sq = 0.f;
#pragma unroll
                for (int bj = 0; bj < 2; ++bj) {
                    const f32x4 a0 = acc[ai][bj][m][0], a1 = acc[ai][bj][m][1];
                    u32x4 w; w.x = cvt_pk_bf16(a0[0], a0[1]); w.y = cvt_pk_bf16(a0[2], a0[3]); w.z = cvt_pk_bf16(a1[0], a1[1]); w.w = cvt_pk_bf16(a1[2], a1[3]);
                    *(GAS u32x4*)(XB + (size_t)row * D + col0 + bj * 128) = w;
                    sq += sq8(w);
                }
                sq += __shfl_xor(sq, 16); sq += __shfl_xor(sq, 32);
                if (fq == 0) sso[(size_t)row * 16 + u.pn * 4 + wc] = sq;
            }
    }
};
struct EpiPL {
    static constexpr bool PERM = true, HAS_INIT = false, USES_RS = true;
    const GAS bf16_t* XI; GAS bf16_t* XO; const GAS float* ssi; GAS float* sso; const GAS bf16_t* PP;
    __device__ __forceinline__ const GAS float* rs_src() const { return ssi; }
    __device__ __forceinline__ void operator()(AccRef acc, const Unit& u, int wr, int wc, int fr, int fq, const LAS float* rsl) const {
        const int row0 = u.pm * 256 + wr * 64 + fr, col0 = u.pn * 256 + wc * 32 + 8 * fq;
        u32x4 xw[2], pw[2];
        { const size_t off = (size_t)row0 * D + col0; xw[0] = *(const GAS u32x4*)(XI + off); pw[0] = *(const GAS u32x4*)(PP + off); }
        float sq = 0.f;
#pragma unroll
        for (int t = 0; t < 16; ++t) {
            const int ai = t >> 3, m = (t >> 1) & 3, bj = t & 1;
            const int row = row0 + ai * 128 + m * 16;
            const size_t off = (size_t)row * D + col0 + bj * 128;
            if (t < 15) { const int t1 = t + 1, ai1 = t1 >> 3, m1 = (t1 >> 1) & 3, bj1 = t1 & 1;
                const size_t off1 = (size_t)(row0 + ai1 * 128 + m1 * 16) * D + col0 + bj1 * 128;
                xw[t1 & 1] = *(const GAS u32x4*)(XI + off1); pw[t1 & 1] = *(const GAS u32x4*)(PP + off1); }
            const float rs = rsl[ai * 128 + wr * 64 + m * 16 + fr];
            const u32x4 xv = xw[t & 1], pv = pw[t & 1];
            const f32x4 g0 = acc[ai][bj][m][0] * rs, g1 = acc[ai][bj][m][1] * rs;
            u32x4 w;
            w.x = cvt_pk_bf16(bf_lo(xv.x) + fast_sigmoid(g0[0]) * bf_lo(pv.x), bf_hi(xv.x) + fast_sigmoid(g0[1]) * bf_hi(pv.x));
            w.y = cvt_pk_bf16(bf_lo(xv.y) + fast_sigmoid(g0[2]) * bf_lo(pv.y), bf_hi(xv.y) + fast_sigmoid(g0[3]) * bf_hi(pv.y));
            w.z = cvt_pk_bf16(bf_lo(xv.z) + fast_sigmoid(g1[0]) * bf_lo(pv.z), bf_hi(xv.z) + fast_sigmoid(g1[1]) * bf_hi(pv.z));
            w.w = cvt_pk_bf16(bf_lo(xv.w) + fast_sigmoid(g1[2]) * bf_lo(pv.w), bf_hi(xv.w) + fast_sigmoid(g1[3]) * bf_hi(pv.w));
            *(GAS u32x4*)(XO + off) = w;
            sq += sq8(w);
            if (bj == 1) {
                sq += __shfl_xor(sq, 16); sq += __shfl_xor(sq, 32);
                if (fq == 0) sso[(size_t)row * 16 + u.pn * 4 + wc] = sq;
                sq = 0.f;
            }
        }
    }
};
struct EpiRetIn {
    static constexpr bool PERM = true, HAS_INIT = false, USES_RS = true;
    GAS bf16_t* O; const GAS float* ssp; const GAS float* cosT; const GAS float* sinT; GAS bf16_t* QF;
    __device__ __forceinline__ const GAS float* rs_src() const { return ssp; }
    __device__ __forceinline__ void operator()(AccRef acc, const Unit& u, int wr, int wc, int fr, int fq, const LAS float* rsl) const {
        const int row0 = u.pm * 256 + wr * 64 + fr, col0 = u.pn * 256 + wc * 32 + 8 * fq;
        const int pn = u.pn;
        f32x4 csb[2][2], snb[2][2];
        if (pn < 8) { const size_t tb = (size_t)(row0 & (SEQ - 1)) * 128 + wc * 32 + 8 * fq;
            csb[0][0] = *(const GAS f32x4*)(cosT + tb); csb[0][1] = *(const GAS f32x4*)(cosT + tb + 4); snb[0][0] = *(const GAS f32x4*)(sinT + tb); snb[0][1] = *(const GAS f32x4*)(sinT + tb + 4); }
#pragma unroll
        for (int ai = 0; ai < 2; ++ai)
#pragma unroll
            for (int m = 0; m < 4; ++m) {
                const int row = row0 + ai * 128 + m * 16;
                const float rs = rsl[ai * 128 + wr * 64 + m * 16 + fr];
                GAS bf16_t* rowp = O + (size_t)row * 6144 + col0;
                if (pn < 8) {
                    const int pos = row & (SEQ - 1);
                    const float ksc = (pn >= 4) ? 0.0625f : 1.f;
                    const int tcur = ai * 4 + m;
                    if (tcur < 7) { const int t1 = tcur + 1; const size_t tb = (size_t)((row0 + (t1 >> 2) * 128 + (t1 & 3) * 16) & (SEQ - 1)) * 128 + wc * 32 + 8 * fq;
                        csb[t1 & 1][0] = *(const GAS f32x4*)(cosT + tb); csb[t1 & 1][1] = *(const GAS f32x4*)(cosT + tb + 4); snb[t1 & 1][0] = *(const GAS f32x4*)(sinT + tb); snb[t1 & 1][1] = *(const GAS f32x4*)(sinT + tb + 4); }
                    f32x4 o1[2], o2[2];
#pragma unroll
                    for (int n = 0; n < 2; ++n) {
                        const f32x4 cs = csb[tcur & 1][n], sn = snb[tcur & 1][n];
                        const f32x4 v1 = acc[ai][0][m][n] * rs, v2 = acc[ai][1][m][n] * rs;
                        o1[n] = (v1 * cs - v2 * sn) * ksc; o2[n] = (v2 * cs + v1 * sn) * ksc;
                    }
                    u32x4 w, w2; w.x = cvt_pk_bf16(o1[0][0], o1[0][1]); w.y = cvt_pk_bf16(o1[0][2], o1[0][3]); w.z = cvt_pk_bf16(o1[1][0], o1[1][1]); w.w = cvt_pk_bf16(o1[1][2], o1[1][3]);
                    w2.x = cvt_pk_bf16(o2[0][0], o2[0][1]); w2.y = cvt_pk_bf16(o2[0][2], o2[0][3]); w2.z = cvt_pk_bf16(o2[1][0], o2[1][1]); w2.w = cvt_pk_bf16(o2[1][2], o2[1][3]);
                    if (pn < 4) {
                        const int bq = row >> 11, nq = (pos >> 7), cq = pos & 127, ctq = cq >> 5, rq = cq & 31;
                        const size_t fb = ((((size_t)(bq * 4 + pn) * 16 + nq) * 4 + ctq) * 16 + 2 * wc + (fq >> 1)) * 2 + (fq & 1);
                        *(GAS u32x4*)(QF + (fb * 32 + rq) * 8) = w;
                        *(GAS u32x4*)(QF + ((fb + 16) * 32 + rq) * 8) = w2;
                    } else {
                        *(GAS u32x4*)(rowp) = w;
                        *(GAS u32x4*)(rowp + 128) = w2;
                    }
                } else {
#pragma unroll
                    for (int bj = 0; bj < 2; ++bj) {
                        f32x4 v0 = acc[ai][bj][m][0] * rs, v1 = acc[ai][bj][m][1] * rs;
                        if (pn >= 16) {
#pragma unroll
                            for (int e = 0; e < 4; ++e) { v0[e] = v0[e] * fast_sigmoid(v0[e]); v1[e] = v1[e] * fast_sigmoid(v1[e]); }
                        }
                        u32x4 w; w.x = cvt_pk_bf16(v0[0], v0[1]); w.y = cvt_pk_bf16(v0[2], v0[3]); w.z = cvt_pk_bf16(v1[0], v1[1]); w.w = cvt_pk_bf16(v1[2], v1[3]);
                        *(GAS u32x4*)(rowp + bj * 128) = w;
                    }
                }
            }
    }
};
struct EpiSguIn {
    static constexpr bool PERM = true, HAS_INIT = false, USES_RS = true;
    GAS bf16_t* O; const GAS float* ssp; GAS float* ssv;
    __device__ __forceinline__ const GAS float* rs_src() const { return ssp; }
    __device__ __forceinline__ void operator()(AccRef acc, const Unit& u, int wr, int wc, int fr, int fq, const LAS float* rsl) const {
        const int row0 = u.pm * 256 + wr * 64 + fr, col0 = u.pn * 256 + wc * 32 + 8 * fq;
#pragma unroll
        for (int ai = 0; ai < 2; ++ai)
#pragma unroll
            for (int m = 0; m < 4; ++m) {
                const int row = row0 + ai * 128 + m * 16;
                const float rs = rsl[ai * 128 + wr * 64 + m * 16 + fr];
                GAS bf16_t* rowp = O + (size_t)row * 4096 + col0;
                float sq = 0.f;
#pragma unroll
                for (int bj = 0; bj < 2; ++bj) {
                    f32x4 v0 = acc[ai][bj][m][0] * rs, v1 = acc[ai][bj][m][1] * rs;
#pragma unroll
                    for (int e = 0; e < 4; ++e) { v0[e] = gelu_tanh(v0[e]); v1[e] = gelu_tanh(v1[e]); }
                    u32x4 w; w.x = cvt_pk_bf16(v0[0], v0[1]); w.y = cvt_pk_bf16(v0[2], v0[3]); w.z = cvt_pk_bf16(v1[0], v1[1]); w.w = cvt_pk_bf16(v1[2], v1[3]);
                    *(GAS u32x4*)(rowp + bj * 128) = w;
                    sq += (v0[0] * v0[0] + v0[1] * v0[1]) + (v0[2] * v0[2] + v0[3] * v0[3]) + (v1[0] * v1[0] + v1[1] * v1[1]) + (v1[2] * v1[2] + v1[3] * v1[3]);
                }
                if (u.pn >= 8) {
                    sq += __shfl_xor(sq, 16); sq += __shfl_xor(sq, 32);
                    if (fq == 0) ssv[(size_t)row * 32 + (u.pn - 8) * 4 + wc] = sq;
                }
            }
    }
};


__device__ __forceinline__ float dpp_ror1(float v) { return __builtin_bit_cast(float, __builtin_amdgcn_update_dpp(0, __builtin_bit_cast(int, v), 0x121, 0xf, 0xf, false)); }
__device__ __forceinline__ float dpp_ror2(float v) { return __builtin_bit_cast(float, __builtin_amdgcn_update_dpp(0, __builtin_bit_cast(int, v), 0x122, 0xf, 0xf, false)); }
struct EpiFfnConv {
    static constexpr bool PERM = true, HAS_INIT = false, USES_RS = true;
    GAS bf16_t* ACT; const GAS float* ssp; const GAS float* cw; const GAS float* cb; GAS float* SG; GAS float* SU;
    __device__ __forceinline__ const GAS float* rs_src() const { return ssp; }
    __device__ __forceinline__ void operator()(AccRef acc, const Unit& u, int wr, int wc, int fr, int fq, const LAS float* rsl) const {
        const int f0 = u.pn * 128 + wc * 32 + 8 * fq;
        float w0[8], w1[8], w2[8], bb[8];
        { const f32x4 t0 = *(const GAS f32x4*)(cw + f0), t1 = *(const GAS f32x4*)(cw + f0 + 4);
          const f32x4 t2 = *(const GAS f32x4*)(cw + FFN + f0), t3 = *(const GAS f32x4*)(cw + FFN + f0 + 4);
          const f32x4 t4 = *(const GAS f32x4*)(cw + 2 * FFN + f0), t5 = *(const GAS f32x4*)(cw + 2 * FFN + f0 + 4);
          const f32x4 t6 = *(const GAS f32x4*)(cb + f0), t7 = *(const GAS f32x4*)(cb + f0 + 4);
#pragma unroll
          for (int e = 0; e < 4; ++e) { w0[e] = t0[e]; w0[4 + e] = t1[e]; w1[e] = t2[e]; w1[4 + e] = t3[e]; w2[e] = t4[e]; w2[4 + e] = t5[e]; bb[e] = t6[e]; bb[4 + e] = t7[e]; } }
#pragma unroll
        for (int ai = 0; ai < 2; ++ai) {
            const int blk64 = u.pm * 4 + ai * 2 + wr;
            float gp[8];
#pragma unroll
            for (int e = 0; e < 8; ++e) gp[e] = 0.f;
#pragma unroll
            for (int m = 0; m < 4; ++m) {
                const int row = u.pm * 256 + ai * 128 + wr * 64 + m * 16 + fr;
                const float rs = rsl[ai * 128 + wr * 64 + m * 16 + fr];
                const f32x4 g0 = acc[ai][0][m][0] * rs, g1v = acc[ai][0][m][1] * rs, u0 = acc[ai][1][m][0] * rs, u1 = acc[ai][1][m][1] * rs;
                float g[8], up[8], o[8];
#pragma unroll
                for (int e = 0; e < 4; ++e) { g[e] = g0[e]; g[4 + e] = g1v[e]; up[e] = u0[e]; up[4 + e] = u1[e]; }
                if (m == 0 && fr < 2) {
                    GAS float* sg = SG + ((size_t)blk64 * 4 + fr) * FFN + f0; GAS float* su = SU + ((size_t)blk64 * 2 + fr) * FFN + f0;
                    *(GAS f32x4*)sg = g0; *(GAS f32x4*)(sg + 4) = g1v; *(GAS f32x4*)su = u0; *(GAS f32x4*)(su + 4) = u1;
                }
                if (m == 3 && fr >= 14) {
                    GAS float* sg = SG + ((size_t)blk64 * 4 + 2 + (fr - 14)) * FFN + f0;
                    *(GAS f32x4*)sg = g0; *(GAS f32x4*)(sg + 4) = g1v;
                }
#pragma unroll
                for (int e = 0; e < 8; ++e) {
                    const float x1 = (fr == 15) ? gp[e] : g[e], x2 = (fr >= 14) ? gp[e] : g[e];
                    const float gm1 = dpp_ror1(x1), gm2 = dpp_ror2(x2);
                    const float cv = bb[e] + w0[e] * gm2 + w1[e] * gm1 + w2[e] * g[e];
                    o[e] = cv * fast_sigmoid(cv) * up[e];
                    gp[e] = g[e];
                }
                if (!(m == 0 && fr < 2)) {
                    u32x4 w; w.x = cvt_pk_bf16(o[0], o[1]); w.y = cvt_pk_bf16(o[2], o[3]); w.z = cvt_pk_bf16(o[4], o[5]); w.w = cvt_pk_bf16(o[6], o[7]);
                    *(GAS u32x4*)(ACT + (size_t)row * FFN + f0) = w;
                }
            }
        }
    }
};
__device__ __forceinline__ void ffn_fixup(GAS bf16_t* __restrict__ act, const GAS float* __restrict__ SG, const GAS float* __restrict__ SU, const GAS float* __restrict__ cw, const GAS float* __restrict__ cb, int pm) {
    constexpr int NCG = FFN / 8;
#pragma unroll 3
    for (int it = opq_tid(); it < 8 * NCG; it += 512) {
        const int bq = it / (2 * NCG), rem = it - bq * 2 * NCG, rr = rem / NCG, f0 = (rem - rr * NCG) * 8;
        const int blk64 = pm * 4 + bq, row = blk64 * 64 + rr;
        const bool first = ((blk64 * 64) & (SEQ - 1)) == 0;
        const GAS float* c0 = SG + ((size_t)blk64 * 4) * FFN + f0;
        const GAS float* pv = SG + ((size_t)(blk64 - 1) * 4 + 2) * FFN + f0;
        float gm2[8], gm1[8], gc[8], up[8];
#pragma unroll
        for (int e = 0; e < 8; ++e) { gm2[e] = 0.f; gm1[e] = 0.f; }
        if (rr == 0) {
            if (!first) { const f32x4 a = *(const GAS f32x4*)pv, b = *(const GAS f32x4*)(pv + 4), c = *(const GAS f32x4*)(pv + FFN), d = *(const GAS f32x4*)(pv + FFN + 4);
#pragma unroll
                for (int e = 0; e < 4; ++e) { gm2[e] = a[e]; gm2[4 + e] = b[e]; gm1[e] = c[e]; gm1[4 + e] = d[e]; } }
            const f32x4 a = *(const GAS f32x4*)c0, b = *(const GAS f32x4*)(c0 + 4);
#pragma unroll
            for (int e = 0; e < 4; ++e) { gc[e] = a[e]; gc[4 + e] = b[e]; }
        } else {
            if (!first) { const f32x4 c = *(const GAS f32x4*)(pv + FFN), d = *(const GAS f32x4*)(pv + FFN + 4);
#pragma unroll
                for (int e = 0; e < 4; ++e) { gm2[e] = c[e]; gm2[4 + e] = d[e]; } }
            const f32x4 a = *(const GAS f32x4*)c0, b = *(const GAS f32x4*)(c0 + 4), c = *(const GAS f32x4*)(c0 + FFN), d = *(const GAS f32x4*)(c0 + FFN + 4);
#pragma unroll
            for (int e = 0; e < 4; ++e) { gm1[e] = a[e]; gm1[4 + e] = b[e]; gc[e] = c[e]; gc[4 + e] = d[e]; }
        }
        { const GAS float* su = SU + ((size_t)blk64 * 2 + rr) * FFN + f0; const f32x4 a = *(const GAS f32x4*)su, b = *(const GAS f32x4*)(su + 4);
#pragma unroll
          for (int e = 0; e < 4; ++e) { up[e] = a[e]; up[4 + e] = b[e]; } }
        float o[8];
#pragma unroll
        for (int e = 0; e < 8; ++e) { const float cv = cb[f0 + e] + cw[f0 + e] * gm2[e] + cw[FFN + f0 + e] * gm1[e] + cw[2 * FFN + f0 + e] * gc[e]; o[e] = cv * fast_sigmoid(cv) * up[e]; }
        u32x4 w; w.x = cvt_pk_bf16(o[0], o[1]); w.y = cvt_pk_bf16(o[2], o[3]); w.z = cvt_pk_bf16(o[4], o[5]); w.w = cvt_pk_bf16(o[6], o[7]);
        *(GAS u32x4*)(act + (size_t)row * FFN + f0) = w;
    }
}

__device__ __forceinline__ void transpose_item(const GAS float* W, const GAS float* gain, int K, int N, GAS bf16_t* WT, LAS float* scr, int item, int lane, int perm) {
    const int nblk = N / 32, kb = item / nblk, nb = item % nblk, k0 = 64 * kb, n0 = 32 * nb;
    f32x4 wv[8];
#pragma unroll
    for (int i = 0; i < 8; ++i) { const int kk = 8 * i + (lane >> 3); wv[i] = *(const GAS f32x4*)(W + (size_t)(k0 + kk) * N + n0 + 4 * (lane & 7)); }
#pragma unroll
    for (int i = 0; i < 8; ++i) { const int kk = 8 * i + (lane >> 3); const float g = gain ? gain[k0 + kk] : 1.f; LAS float* d = scr + kk * 33 + 4 * (lane & 7);
        d[0] = wv[i].x * g; d[1] = wv[i].y * g; d[2] = wv[i].z * g; d[3] = wv[i].w * g; }
    asm volatile("s_waitcnt lgkmcnt(0)" ::: "memory");
    const int c = lane & 7;
#pragma unroll
    for (int j = 0; j < 4; ++j) { const int n = (lane >> 3) + 8 * j; const LAS float* s = scr + (8 * c) * 33 + n;
        u32x4 o; o.x = cvt_pk_bf16(s[0 * 33], s[1 * 33]); o.y = cvt_pk_bf16(s[2 * 33], s[3 * 33]); o.z = cvt_pk_bf16(s[4 * 33], s[5 * 33]); o.w = cvt_pk_bf16(s[6 * 33], s[7 * 33]);
        int nr = n0 + n; if (perm) { const int isup = nr >= FFN, f = isup ? nr - FFN : nr; nr = (f >> 7) * 256 + (isup ? 128 : 0) + (f & 127); }
        *(GAS u32x4*)(WT + (size_t)nr * K + k0 + 8 * c) = o; }
    asm volatile("s_waitcnt lgkmcnt(0)" ::: "memory");
}
__device__ __forceinline__ void prep_phase(const Params& P, LAS unsigned char* lds, int G, int cblk) {
    const int tid = opq_tid(), lane = tid & 63, wave = __builtin_amdgcn_readfirstlane(tid >> 6);
    LAS float* scr = (LAS float*)(lds + wave * 16384);
    const int gw = cblk * 8 + wave, NGW = G * 8;
    int base = 0;
#pragma unroll 1
    for (int mi = 0; mi < 24; ++mi) {
        const GAS float* W = (const GAS float*)P.mats[mi].W; const GAS float* gain = (const GAS float*)P.mats[mi].gain; GAS bf16_t* dst = (GAS bf16_t*)P.mats[mi].dst; const int K = P.mats[mi].K, N = P.mats[mi].N, perm = P.mats[mi].perm;
        const int items = (K / 64) * (N / 32);
        int start = ((gw - base) % NGW + NGW) % NGW;
        for (int it = start; it < items; it += NGW) transpose_item(W, gain, K, N, dst, scr, it, lane, perm);
        base += items;
    }
    GAS float* cosT = (GAS float*)(P.ws + OFF_COS); GAS float* sinT = (GAS float*)(P.ws + OFF_SIN);
    for (int i = cblk * 512 + tid; i < SEQ * 128; i += G * 512) {
        const int pos = i >> 7, fi = i & 127;
        const double inv = exp(-(double)fi * (9.210340371976184 / 128.0));
        const double ang = (double)pos * inv;
        const double TWO_PI = 6.283185307179586476925;
        const double r = ang - rint(ang / TWO_PI) * TWO_PI;
        const double r2 = r * r;
        double s = 1.0 / 51090942171709440000.0;
        s = s * (-r2) + 1.0 / 121645100408832000.0; s = s * (-r2) + 1.0 / 355687428096000.0; s = s * (-r2) + 1.0 / 1307674368000.0; s = s * (-r2) + 1.0 / 6227020800.0;
        s = s * (-r2) + 1.0 / 39916800.0; s = s * (-r2) + 1.0 / 362880.0; s = s * (-r2) + 1.0 / 5040.0; s = s * (-r2) + 1.0 / 120.0; s = s * (-r2) + 1.0 / 6.0; s = s * (-r2) + 1.0;
        s *= r;
        double c = 1.0 / 2432902008176640000.0;
        c = c * (-r2) + 1.0 / 6402373705728000.0; c = c * (-r2) + 1.0 / 20922789888000.0; c = c * (-r2) + 1.0 / 87178291200.0; c = c * (-r2) + 1.0 / 479001600.0;
        c = c * (-r2) + 1.0 / 3628800.0; c = c * (-r2) + 1.0 / 40320.0; c = c * (-r2) + 1.0 / 720.0; c = c * (-r2) + 1.0 / 24.0; c = c * (-r2) + 0.5; c = c * (-r2) + 1.0;
        cosT[i] = (float)c; sinT[i] = (float)s;
    }
}

__device__ __forceinline__ void load_half_phase(const GAS float* xin, GAS bf16_t* xb, GAS float* sso, int G, int cblk) {
    const int tid = opq_tid(), lane = tid & 63, wave = tid >> 6;
    for (int row = cblk * 8 + wave; row < TH; row += G * 8) {
        const GAS f32x4* xr = (const GAS f32x4*)(xin + (size_t)row * D) + lane;
        GAS u32x2* bo = (GAS u32x2*)(xb + (size_t)row * D) + lane;
        float s = 0.f;
#pragma unroll
        for (int j = 0; j < 4; ++j) { const f32x4 v = xr[64 * j]; u32x2 w; w.x = cvt_pk_bf16(v.x, v.y); w.y = cvt_pk_bf16(v.z, v.w); bo[64 * j] = w;
            const float a0 = bf_lo(w.x), a1 = bf_hi(w.x), a2 = bf_lo(w.y), a3 = bf_hi(w.y); s += (a0 * a0 + a1 * a1) + (a2 * a2 + a3 * a3); }
        s = wave_sum(s);
        if (lane < 16) sso[(size_t)row * 16 + lane] = (lane == 0) ? s : 0.f;
    }
}
__device__ __forceinline__ void pconv_phase(const GAS float* __restrict__ pin, GAS bf16_t* __restrict__ pb, int G, int cblk) {
#pragma unroll 4
    for (int i = cblk * 512 + opq_tid(); i < TH * PLD / 8; i += G * 512) {
        const f32x4 a = *(const GAS f32x4*)(pin + (size_t)i * 8), b = *(const GAS f32x4*)(pin + (size_t)i * 8 + 4);
        u32x4 w; w.x = cvt_pk_bf16(a.x, a.y); w.y = cvt_pk_bf16(a.z, a.w); w.z = cvt_pk_bf16(b.x, b.y); w.w = cvt_pk_bf16(b.z, b.w);
        *(GAS u32x4*)(pb + (size_t)i * 8) = w;
    }
}
__device__ __forceinline__ void final_phase(const GAS bf16_t* xb, GAS float* out, const GAS float* gf, int G, int cblk) {
    const int tid = opq_tid(), lane = tid & 63, wave = tid >> 6;
    for (int row = cblk * 8 + wave; row < TH; row += G * 8) {
        const GAS u32x4* xr = (const GAS u32x4*)(xb + (size_t)row * D) + lane;
        GAS f32x4* orow = (GAS f32x4*)(out + (size_t)row * D);
        const u32x4 w0 = xr[0], w1 = xr[64];
        float s = wave_sum(sq8(w0) + sq8(w1));
        const float rs = 1.f / sqrtf(s * (1.f / 1024.f) + EPS);
#pragma unroll
        for (int j = 0; j < 2; ++j) {
            const u32x4 w = j ? w1 : w0;
            const int c0 = 8 * lane + 512 * j;
            const f32x4 ga = *(const GAS f32x4*)(gf + c0), gb = *(const GAS f32x4*)(gf + c0 + 4);
            f32x4 oa, ob;
            oa.x = bf_lo(w.x) * rs * ga.x; oa.y = bf_hi(w.x) * rs * ga.y; oa.z = bf_lo(w.y) * rs * ga.z; oa.w = bf_hi(w.y) * rs * ga.w;
            ob.x = bf_lo(w.z) * rs * gb.x; ob.y = bf_hi(w.z) * rs * gb.y; ob.z = bf_lo(w.w) * rs * gb.z; ob.w = bf_hi(w.w) * rs * gb.w;
            orow[c0 / 4] = oa; orow[c0 / 4 + 1] = ob;
        }
    }
}
template <int NKS>
__device__ __forceinline__ f32x16 lds_feed_mfma(LAS unsigned char* p, const bf16x8* bq, f32x16 acc) {
    static_assert(NKS % 2 == 0, "groups of two k-steps");
    bf16x8 a[2][2];
#pragma unroll
    for (int j = 0; j < 2; ++j) a[0][j] = *(const LAS bf16x8*)(p + 32 * j);
#pragma unroll
    for (int g = 0; g < NKS / 2; ++g) {
        if (g + 1 < NKS / 2) {
#pragma unroll
            for (int j = 0; j < 2; ++j) a[(g + 1) & 1][j] = *(const LAS bf16x8*)(p + 32 * (2 * (g + 1) + j));
        }
        __builtin_amdgcn_sched_barrier(0);
        __builtin_amdgcn_s_setprio(1);
#pragma unroll
        for (int j = 0; j < 2; ++j) acc = mfma32(a[g & 1][j], bq[2 * g + j], acc);
        __builtin_amdgcn_s_setprio(0);
        __builtin_amdgcn_sched_barrier(0);
    }
    return acc;
}
__device__ __forceinline__ void sb_tile_tail(const f32x16& s, const bool diag, const int r, const int hh, float& carry, f32x16 (&oacc)[2], LAS unsigned char* vt) {
    constexpr int RS_ = 144;
    const float C = 0.125f * LOG2E;
    float be[16], kp[16];
#pragma unroll
    for (int e2 = 0; e2 < 8; ++e2) {
        f32x2 sv; sv.x = s[2 * e2]; sv.y = s[2 * e2 + 1];
        const f32x2 z2 = sv * (-C);
        f32x2 ex; ex.x = __builtin_amdgcn_exp2f(z2.x); ex.y = __builtin_amdgcn_exp2f(z2.y);
        const f32x2 d = ex + 1.f;
        f32x2 b2; b2.x = __builtin_amdgcn_rcpf(d.x); b2.y = __builtin_amdgcn_rcpf(d.y);
        const f32x2 k2 = 1.f - b2;
        be[2 * e2] = b2.x; be[2 * e2 + 1] = b2.y; kp[2 * e2] = k2.x; kp[2 * e2 + 1] = k2.y;
    }
    if (diag) {
#pragma unroll
        for (int e = 0; e < 16; ++e) { const int kidx = 8 * (e >> 2) + 4 * hh + (e & 3); const bool valid = kidx < r; be[e] = valid ? be[e] : 0.f; kp[e] = valid ? kp[e] : 1.f; }
    }
    float Gs[4], PG[4];
#pragma unroll
    for (int i = 0; i < 4; ++i) { Gs[i] = (kp[4 * i] * kp[4 * i + 1]) * (kp[4 * i + 2] * kp[4 * i + 3]); PG[i] = __shfl_xor(Gs[i], 32); }
    float R[4]; R[3] = 1.f; R[2] = Gs[3] * PG[3]; R[1] = R[2] * (Gs[2] * PG[2]); R[0] = R[1] * (Gs[1] * PG[1]);
    const float tot = R[0] * (Gs[0] * PG[0]);
    float A[16];
#pragma unroll
    for (int i = 0; i < 4; ++i) {
        const float b3 = carry * R[i] * (hh == 0 ? PG[i] : 1.f);
        const float b2 = b3 * kp[4 * i + 3], b1 = b2 * kp[4 * i + 2], b0 = b1 * kp[4 * i + 1];
        A[4 * i + 3] = be[4 * i + 3] * b3; A[4 * i + 2] = be[4 * i + 2] * b2; A[4 * i + 1] = be[4 * i + 1] * b1; A[4 * i] = be[4 * i] * b0;
    }
    carry *= tot;
    const bf16x8 pf0 = pack8(A[0], A[1], A[2], A[3], A[4], A[5], A[6], A[7]), pf1 = pack8(A[8], A[9], A[10], A[11], A[12], A[13], A[14], A[15]);
#pragma unroll
    for (int dvt = 0; dvt < 2; ++dvt) {
        const bf16x8 a0 = cat4(tr_read(vt + dvt * 64), tr_read(vt + dvt * 64 + 8 * RS_));
        const bf16x8 a1 = cat4(tr_read(vt + dvt * 64 + 16 * RS_), tr_read(vt + dvt * 64 + 24 * RS_));
        oacc[dvt] = mfma32(a0, pf0, oacc[dvt]);
        oacc[dvt] = mfma32(a1, pf1, oacc[dvt]);
    }
}
__device__ __forceinline__ f32x16 sb_tile_qk(LAS unsigned char* kt, const bf16x8 (&qf)[4]) {
    f32x16 s;
#pragma unroll
    for (int e = 0; e < 16; ++e) s[e] = 0.f;
    s = lds_feed_mfma<4>(kt, qf, s);
    return s;
}
__device__ __forceinline__ void sb_attn_phase(const GAS bf16_t* qkv, GAS bf16_t* o, LAS unsigned char* lds, int G, int cblk) {
    const int tid = opq_tid(), lane = tid & 63, w = __builtin_amdgcn_readfirstlane(tid >> 6), r = lane & 31, hh = lane >> 5;
    const int blk = (lane >> 4) & 1, tq = (lane & 15) >> 2, tp = lane & 3;
    constexpr int RS_ = 144, CH = 128, BUF = CH * RS_;
    LAS unsigned char* Kb = lds; LAS unsigned char* Vb = lds + 2 * BUF;
    const int srow = tid >> 3, spc = tid & 7;
#pragma unroll 1
    for (int u = cblk; u < 1024; u += G) {
        const int grp = u >> 7, qb = (0x10235467u >> (4 * grp)) & 7, bh = u & 127, b = bh >> 4, h = bh & 15;
        const size_t seq0 = (size_t)b * SEQ;
        const int Q0 = qb * 256 + 32 * w;
        bf16x8 qf[4];
#pragma unroll
        for (int ks = 0; ks < 4; ++ks) qf[ks] = *(const GAS bf16x8*)(qkv + (seq0 + Q0 + r) * 3072 + h * 64 + 16 * ks + 8 * hh);
        f32x16 oacc[2];
#pragma unroll
        for (int e = 0; e < 16; ++e) { oacc[0][e] = 0.f; oacc[1][e] = 0.f; }
        float carry = 1.f;
        const int nch = qb * 2 + 2;
        volatile LAS unsigned* flg = (volatile LAS unsigned*)(lds + 131072 + 64);
        if (tid < 3) flg[tid] = 0u;
#pragma unroll
        for (int i = 0; i < 2; ++i) { const GAS bf16_t* gk = qkv + (seq0 + (size_t)(nch - 1) * CH + srow + 64 * i) * 3072 + 1024 + h * 64 + spc * 8;
          const u32x4 kq = *(const GAS u32x4*)gk, vq = *(const GAS u32x4*)(gk + 1024);
          *(LAS u32x4*)(Kb + (srow + 64 * i) * RS_ + spc * 16) = kq; *(LAS u32x4*)(Vb + (srow + 64 * i) * RS_ + spc * 16) = vq; }
        LDS_BARRIER();
        bool walive = true;
        int fi = 0;
#pragma unroll 1
        for (int kc = nch - 1; kc >= 0; --kc) {
            const int buf = (nch - 1 - kc) & 1;
            const int fnx = (fi == 2) ? 0 : fi + 1;
            if (tid == 0) flg[fnx] = 0u;
            u32x4 kq[2], vq[2];
            if (kc > 0) {
#pragma unroll
                for (int i = 0; i < 2; ++i) { const GAS bf16_t* gk = qkv + (seq0 + (size_t)(kc - 1) * CH + srow + 64 * i) * 3072 + 1024 + h * 64 + spc * 8; kq[i] = *(const GAS u32x4*)gk; vq[i] = *(const GAS u32x4*)(gk + 1024); }
            }
            if (walive) {
                LAS unsigned char* kt0 = Kb + buf * BUF + r * RS_ + 16 * hh;
                LAS unsigned char* vt0 = Vb + buf * BUF + (4 * hh + tq) * RS_ + (16 * blk + 4 * tp) * 2;
                if (kc * CH + 96 < Q0) {
                    f32x16 sv[4];
#pragma unroll
                    for (int tl = 0; tl < 4; ++tl) sv[tl] = sb_tile_qk(kt0 + 32 * tl * RS_, qf);
#pragma unroll
                    for (int tl = 3; tl >= 0; --tl) sb_tile_tail(sv[tl], false, r, hh, carry, oacc, vt0 + 32 * tl * RS_);
                } else {
#pragma unroll 1
                    for (int tl = 3; tl >= 0; --tl) {
                        const int ks0 = kc * CH + 32 * tl;
                        if (ks0 > Q0) continue;
                        const f32x16 s = sb_tile_qk(kt0 + 32 * tl * RS_, qf);
                        sb_tile_tail(s, ks0 == Q0, r, hh, carry, oacc, vt0 + 32 * tl * RS_);
                    }
                }
                walive = __builtin_amdgcn_ballot_w64(carry != 0.f) != 0ull;
                if (walive && lane == 0) flg[fi] = 1u;
            }
            if (kc > 0) {
#pragma unroll
                for (int i = 0; i < 2; ++i) { *(LAS u32x4*)(Kb + (buf ^ 1) * BUF + (srow + 64 * i) * RS_ + spc * 16) = kq[i]; *(LAS u32x4*)(Vb + (buf ^ 1) * BUF + (srow + 64 * i) * RS_ + spc * 16) = vq[i]; }
            }
            LDS_BARRIER();
            if (flg[fi] == 0u) break;
            fi = fnx;
        }
        LDS_BARRIER();
        GAS bf16_t* op = o + (seq0 + Q0 + r) * D + h * 64 + 4 * hh;
#pragma unroll
        for (int dvt = 0; dvt < 2; ++dvt)
#pragma unroll
            for (int i = 0; i < 4; ++i) {
                u32x2 wv; wv.x = cvt_pk_bf16(oacc[dvt][4 * i], oacc[dvt][4 * i + 1]); wv.y = cvt_pk_bf16(oacc[dvt][4 * i + 2], oacc[dvt][4 * i + 3]);
                *(GAS u32x2*)(op + 32 * dvt + 8 * i) = wv;
            }
    }
}

__device__ __forceinline__ void ret_core_phase(const GAS bf16_t* proj, const GAS bf16_t* QF, GAS bf16_t* oraw, GAS float* rst, LAS unsigned char* lds, int G, int cblk) {
    const int tid = opq_tid(), lane = tid & 63, w = __builtin_amdgcn_readfirstlane(tid >> 6), r = lane & 31, hh = lane >> 5;
    const int blk = (lane >> 4) & 1, tq = (lane & 15) >> 2, tp = lane & 3;
    constexpr int KSTR = 528, VSTR = 272;
    LAS unsigned char* KS = lds; LAS unsigned char* VT = lds + 128 * KSTR; LAS unsigned char* ST = lds + 128 * KSTR + 64 * VSTR;
    const int ct = w >> 1, et = w & 1;
#pragma unroll 1
    for (int u0 = cblk; u0 < 256; u0 += G) {
        const int u = ((G & 7) == 0 && G <= 256) ? ((((u0 & 7) * 4 + ((u0 >> 3) >> 3)) << 3) | ((u0 >> 3) & 7)) : u0;
        const int b = u >> 5, h = (u >> 3) & 3, es = u & 7;
        const float lg2 = log2f(1.f - exp2f(-5.f - (float)h));
        f32x16 Sacc[2];
#pragma unroll
        for (int e = 0; e < 16; ++e) { Sacc[0][e] = 0.f; Sacc[1][e] = 0.f; }
        u32x4 kreg[8]; bf16x8 qf[16];
        {
            const size_t tk = (size_t)b * SEQ;
#pragma unroll
            for (int i = 0; i < 8; ++i) { const int id = tid + 512 * i, row = id >> 5, pc = id & 31; kreg[i] = *(const GAS u32x4*)(proj + (tk + row) * 6144 + 1024 + h * 256 + pc * 8); }
#pragma unroll
            for (int ks = 0; ks < 16; ++ks) qf[ks] = *(const GAS bf16x8*)(QF + ((((((size_t)(b * 4 + h) * 16 + 0) * 4 + ct) * 16 + ks) * 2 + hh) * 32 + r) * 8);
        }
#pragma unroll 1
        for (int n = 0; n < 16; ++n) {
            const size_t tok0 = (size_t)b * SEQ + n * 128;
            u32x4 vqq[2];
#pragma unroll
            for (int i = 0; i < 2; ++i) { const int id = tid + 512 * i, m = id & 127, pc = id >> 7; vqq[i] = *(const GAS u32x4*)(proj + (tok0 + m) * 6144 + 2048 + h * 512 + es * 64 + pc * 8); }
#pragma unroll
            for (int i = 0; i < 8; ++i) { const int id = tid + 512 * i, row = id >> 5, pc = id & 31; *(LAS u32x4*)(KS + row * KSTR + pc * 16) = kreg[i]; }
#pragma unroll
            for (int i = 0; i < 2; ++i) { const int id = tid + 512 * i, m = id & 127, pc = id >> 7;
                const u32x4 vq = vqq[i];
                const float sc = exp2f(-lg2 * (float)(m + 1));
                const unsigned w0 = cvt_pk_bf16(bf_lo(vq.x) * sc, bf_hi(vq.x) * sc), w1 = cvt_pk_bf16(bf_lo(vq.y) * sc, bf_hi(vq.y) * sc),
                               w2 = cvt_pk_bf16(bf_lo(vq.z) * sc, bf_hi(vq.z) * sc), w3 = cvt_pk_bf16(bf_lo(vq.w) * sc, bf_hi(vq.w) * sc);
                LAS unsigned char* vp = VT + (pc * 8) * VSTR + m * 2;
                *(LAS bf16_t*)(vp + 0 * VSTR) = (bf16_t)(w0 & 0xffff); *(LAS bf16_t*)(vp + 1 * VSTR) = (bf16_t)(w0 >> 16);
                *(LAS bf16_t*)(vp + 2 * VSTR) = (bf16_t)(w1 & 0xffff); *(LAS bf16_t*)(vp + 3 * VSTR) = (bf16_t)(w1 >> 16);
                *(LAS bf16_t*)(vp + 4 * VSTR) = (bf16_t)(w2 & 0xffff); *(LAS bf16_t*)(vp + 5 * VSTR) = (bf16_t)(w2 >> 16);
                *(LAS bf16_t*)(vp + 6 * VSTR) = (bf16_t)(w3 & 0xffff); *(LAS bf16_t*)(vp + 7 * VSTR) = (bf16_t)(w3 >> 16); }
            if (n < 15) {
                const size_t tn = tok0 + 128;
#pragma unroll
                for (int i = 0; i < 8; ++i) { const int id = tid + 512 * i, row = id >> 5, pc = id & 31; kreg[i] = *(const GAS u32x4*)(proj + (tn + row) * 6144 + 1024 + h * 256 + pc * 8); }
            }
            LDS_BARRIER();
            f32x16 oacc;
#pragma unroll
            for (int e = 0; e < 16; ++e) oacc[e] = 0.f;
            if (n > 0) {
                LAS unsigned char* sp = ST + (32 * et + r) * KSTR + 16 * hh;
                oacc = lds_feed_mfma<16>(sp, qf, oacc);
            }
#pragma unroll 1
            for (int mt = 0; mt <= ct; ++mt) {
                f32x16 sT;
#pragma unroll
                for (int e = 0; e < 16; ++e) sT[e] = 0.f;
                LAS unsigned char* kp = KS + (32 * mt + r) * KSTR + 16 * hh;
                sT = lds_feed_mfma<16>(kp, qf, sT);
                if (mt == ct) {
#pragma unroll
                    for (int e = 0; e < 16; ++e) { const int kidx = 8 * (e >> 2) + 4 * hh + (e & 3); sT[e] = (kidx <= r) ? sT[e] : 0.f; }
                }
                const bf16x8 pf0 = pack8(sT[0], sT[1], sT[2], sT[3], sT[4], sT[5], sT[6], sT[7]), pf1 = pack8(sT[8], sT[9], sT[10], sT[11], sT[12], sT[13], sT[14], sT[15]);
                LAS unsigned char* vp = VT + (32 * et + r) * VSTR + (32 * mt + 4 * hh) * 2;
                const bf16x8 a0 = cat4(*(const LAS s16x4*)(vp), *(const LAS s16x4*)(vp + 16));
                const bf16x8 a1 = cat4(*(const LAS s16x4*)(vp + 32), *(const LAS s16x4*)(vp + 48));
                oacc = mfma32(a0, pf0, oacc);
                oacc = mfma32(a1, pf1, oacc);
            }
            {
                const int c = 32 * ct + r;
                const float sc = exp2f(lg2 * (float)(c + 1));
                float s1 = 0.f, s2 = 0.f;
                GAS bf16_t* op = oraw + (tok0 + c) * 2048 + h * 512 + es * 64 + 32 * et + 4 * hh;
#pragma unroll
                for (int i = 0; i < 4; ++i) {
                    const float v0 = oacc[4 * i] * sc, v1 = oacc[4 * i + 1] * sc, v2 = oacc[4 * i + 2] * sc, v3 = oacc[4 * i + 3] * sc;
                    s1 += (v0 + v1) + (v2 + v3); s2 += (v0 * v0 + v1 * v1) + (v2 * v2 + v3 * v3);
                    u32x2 wv; wv.x = cvt_pk_bf16(v0, v1); wv.y = cvt_pk_bf16(v2, v3);
                    *(GAS u32x2*)(op + 8 * i) = wv;
                }
                s1 += __shfl_xor(s1, 32); s2 += __shfl_xor(s2, 32);
                if (hh == 0) { f32x2 st; st.x = s1; st.y = s2; *(GAS f32x2*)(rst + (((tok0 + c) * 4 + h) * 16 + es * 2 + et) * 2) = st; }
            }
            if (n < 15) {
#pragma unroll
                for (int ks = 0; ks < 16; ++ks) qf[ks] = *(const GAS bf16x8*)(QF + ((((((size_t)(b * 4 + h) * 16 + (n + 1)) * 4 + ct) * 16 + ks) * 2 + hh) * 32 + r) * 8);
            }
            {
                LAS unsigned char* kp = KS + (8 * hh + tq) * KSTR + (32 * w + 16 * blk + 4 * tp) * 2;
                LAS unsigned char* vp = VT + r * VSTR + 16 * hh;
                s16x4 tl[2], th[2]; bf16x8 b0[2], b1[2];
                tl[0] = tr_read(kp); th[0] = tr_read(kp + 4 * KSTR); b0[0] = *(const LAS bf16x8*)(vp); b1[0] = *(const LAS bf16x8*)(vp + 32 * VSTR);
#pragma unroll
                for (int ms = 0; ms < 8; ++ms) {
                    if (ms < 7) { tl[(ms + 1) & 1] = tr_read(kp + (16 * (ms + 1)) * KSTR); th[(ms + 1) & 1] = tr_read(kp + (16 * (ms + 1) + 4) * KSTR);
                        b0[(ms + 1) & 1] = *(const LAS bf16x8*)(vp + 32 * (ms + 1)); b1[(ms + 1) & 1] = *(const LAS bf16x8*)(vp + 32 * VSTR + 32 * (ms + 1)); }
                    __builtin_amdgcn_sched_barrier(0);
                    const bf16x8 a = cat4(tl[ms & 1], th[ms & 1]);
                    __builtin_amdgcn_s_setprio(1);
                    Sacc[0] = mfma32(a, b0[ms & 1], Sacc[0]);
                    Sacc[1] = mfma32(a, b1[ms & 1], Sacc[1]);
                    __builtin_amdgcn_s_setprio(0);
                    __builtin_amdgcn_sched_barrier(0);
                }
                const float dc = exp2f(lg2 * 128.f);
#pragma unroll
                for (int e = 0; e < 16; ++e) { Sacc[0][e] *= dc; Sacc[1][e] *= dc; }
            }
            LDS_BARRIER();
#pragma unroll
            for (int e2 = 0; e2 < 2; ++e2)
#pragma unroll
                for (int i = 0; i < 4; ++i) {
                    u32x2 wv; wv.x = cvt_pk_bf16(Sacc[e2][4 * i], Sacc[e2][4 * i + 1]); wv.y = cvt_pk_bf16(Sacc[e2][4 * i + 2], Sacc[e2][4 * i + 3]);
                    *(LAS u32x2*)(ST + (32 * e2 + r) * KSTR + (32 * w + 8 * i + 4 * hh) * 2) = wv;
                }
        }
        LDS_BARRIER();
    }
}
__device__ __forceinline__ void ret_norm_phase(const GAS bf16_t* proj, GAS bf16_t* oraw, const GAS float* rst, int G, int cblk) {
    const int tid = opq_tid(), lane = tid & 63, wave = tid >> 6;
    for (int row = cblk * 8 + wave; row < TH; row += G * 8) {
        const f32x2 st = *(const GAS f32x2*)(rst + ((size_t)row * 64 + lane) * 2);
        u32x4 ov[4], gv[4];
#pragma unroll
        for (int h = 0; h < 4; ++h) { ov[h] = *(const GAS u32x4*)(oraw + (size_t)row * 2048 + h * 512 + lane * 8); gv[h] = *(const GAS u32x4*)(proj + (size_t)row * 6144 + 4096 + h * 512 + lane * 8); }
        float s1 = st.x, s2 = st.y;
#pragma unroll
        for (int o = 1; o < 16; o <<= 1) { s1 += __shfl_xor(s1, o); s2 += __shfl_xor(s2, o); }
#pragma unroll
        for (int h = 0; h < 4; ++h) {
            const float t1 = __shfl(s1, 16 * h), t2 = __shfl(s2, 16 * h);
            const float mu = t1 * (1.f / 512.f);
            const float var = __builtin_fmaxf(t2 * (1.f / 512.f) - mu * mu, 0.f);
            const float rstd = 1.f / sqrtf(var + EPS);
            const u32x4 o4 = ov[h], g4 = gv[h];
            u32x4 wv;
            wv.x = cvt_pk_bf16((bf_lo(o4.x) - mu) * rstd * bf_lo(g4.x), (bf_hi(o4.x) - mu) * rstd * bf_hi(g4.x));
            wv.y = cvt_pk_bf16((bf_lo(o4.y) - mu) * rstd * bf_lo(g4.y), (bf_hi(o4.y) - mu) * rstd * bf_hi(g4.y));
            wv.z = cvt_pk_bf16((bf_lo(o4.z) - mu) * rstd * bf_lo(g4.z), (bf_hi(o4.z) - mu) * rstd * bf_hi(g4.z));
            wv.w = cvt_pk_bf16((bf_lo(o4.w) - mu) * rstd * bf_lo(g4.w), (bf_hi(o4.w) - mu) * rstd * bf_hi(g4.w));
            *(GAS u32x4*)(oraw + (size_t)row * 2048 + h * 512 + lane * 8) = wv;
        }
    }
}

__device__ __forceinline__ void sgu_core_phase(const GAS bf16_t* z, const GAS float* ssv, const GAS float* w_s, const GAS float* b_s, const GAS float* gn, GAS bf16_t* umix, LAS unsigned char* lds, int G, int cblk) {
    const int tid = opq_tid(), lane = tid & 63, w = __builtin_amdgcn_readfirstlane(tid >> 6), r = lane & 31, hh = lane >> 5;
    const int blk = (lane >> 4) & 1, tq = (lane & 15) >> 2, tp = lane & 3;
    constexpr int VSTR = 528, WSTR = 272;
    LAS unsigned char* VI = lds; LAS unsigned char* WI = lds + 128 * VSTR; LAS float* RS = (LAS float*)(lds + 128 * VSTR + 128 * WSTR);
#pragma unroll 1
    for (int u = cblk; u < 1024; u += G) {
        const int g = u & 7, bn = u >> 3;
        const size_t t0 = (size_t)bn * 128;
        if (tid < 128) {
            const GAS f32x4* sp = (const GAS f32x4*)(ssv + (t0 + tid) * 32);
            f32x4 a = sp[0];
#pragma unroll
            for (int i = 1; i < 8; ++i) a += sp[i];
            RS[tid] = __builtin_amdgcn_rsqf(((a.x + a.y) + (a.z + a.w)) * (1.f / 2048.f) + EPS);
        }
#pragma unroll
        for (int i = 0; i < 8; ++i) { const int id = tid + 512 * i, row = id >> 5, pc = id & 31;
            *(LAS u32x4*)(VI + row * VSTR + pc * 16) = *(const GAS u32x4*)(z + (t0 + row) * 4096 + 2048 + g * 256 + pc * 8); }
        LDS_BARRIER();
#pragma unroll
        for (int i = 0; i < 4; ++i) { const int id = tid + 512 * i, t = id >> 4, pc = id & 15;
            const GAS float* wp = w_s + ((size_t)g * 128 + t) * 128 + pc * 8;
            const f32x4 a = *(const GAS f32x4*)wp, b2 = *(const GAS f32x4*)(wp + 4);
            float v[8];
#pragma unroll
            for (int e = 0; e < 4; ++e) { v[e] = a[e]; v[4 + e] = b2[e]; }
#pragma unroll
            for (int e = 0; e < 8; ++e) { const int s = pc * 8 + e; v[e] = (s <= t) ? v[e] * RS[s] : 0.f; }
            u32x4 wv; wv.x = cvt_pk_bf16(v[0], v[1]); wv.y = cvt_pk_bf16(v[2], v[3]); wv.z = cvt_pk_bf16(v[4], v[5]); wv.w = cvt_pk_bf16(v[6], v[7]);
            *(LAS u32x4*)(WI + t * WSTR + pc * 16) = wv; }
        LDS_BARRIER();
        f32x16 acc[4];
#pragma unroll
        for (int tt = 0; tt < 4; ++tt)
#pragma unroll
            for (int e = 0; e < 16; ++e) acc[tt][e] = 0.f;
        LAS unsigned char* vp = VI + (8 * hh + tq) * VSTR + (32 * w + 16 * blk + 4 * tp) * 2;
        LAS unsigned char* wp = WI + r * WSTR + 16 * hh;
        s16x4 tl[2], th[2]; bf16x8 wb[2][4];
        tl[0] = tr_read(vp); th[0] = tr_read(vp + 4 * VSTR);
#pragma unroll
        for (int tt = 0; tt < 4; ++tt) wb[0][tt] = *(const LAS bf16x8*)(wp + (32 * tt) * WSTR);
#pragma unroll
        for (int ks = 0; ks < 8; ++ks) {
            if (ks < 7) { tl[(ks + 1) & 1] = tr_read(vp + (16 * (ks + 1)) * VSTR); th[(ks + 1) & 1] = tr_read(vp + (16 * (ks + 1) + 4) * VSTR);
#pragma unroll
                for (int tt = 0; tt < 4; ++tt) if (ks + 1 <= 2 * tt + 1) wb[(ks + 1) & 1][tt] = *(const LAS bf16x8*)(wp + (32 * tt) * WSTR + 32 * (ks + 1)); }
            __builtin_amdgcn_sched_barrier(0);
            const bf16x8 a = cat4(tl[ks & 1], th[ks & 1]);
            __builtin_amdgcn_s_setprio(1);
#pragma unroll
            for (int tt = 0; tt < 4; ++tt)
                if (ks <= 2 * tt + 1) acc[tt] = mfma32(a, wb[ks & 1][tt], acc[tt]);
            __builtin_amdgcn_s_setprio(0);
            __builtin_amdgcn_sched_barrier(0);
        }
        f32x4 gvv[4]; u32x2 uqq[4][4]; float biasv[4];
#pragma unroll
        for (int i = 0; i < 4; ++i) gvv[i] = *(const GAS f32x4*)(gn + g * 256 + 32 * w + 8 * i + 4 * hh);
#pragma unroll
        for (int tt = 0; tt < 4; ++tt) {
            biasv[tt] = b_s[g * 128 + 32 * tt + r];
#pragma unroll
            for (int i = 0; i < 4; ++i) uqq[tt][i] = *(const GAS u32x2*)(z + (t0 + 32 * tt + r) * 4096 + g * 256 + 32 * w + 8 * i + 4 * hh);
        }
#pragma unroll
        for (int tt = 0; tt < 4; ++tt) {
            const int t = 32 * tt + r;
            const float bias = biasv[tt];
#pragma unroll
            for (int i = 0; i < 4; ++i) {
                const int c4 = g * 256 + 32 * w + 8 * i + 4 * hh;
                const f32x4 gv = gvv[i];
                const u32x2 uq = uqq[tt][i];
                const float o0 = bf_lo(uq.x) * (acc[tt][4 * i] * gv[0] + bias), o1 = bf_hi(uq.x) * (acc[tt][4 * i + 1] * gv[1] + bias);
                const float o2 = bf_lo(uq.y) * (acc[tt][4 * i + 2] * gv[2] + bias), o3 = bf_hi(uq.y) * (acc[tt][4 * i + 3] * gv[3] + bias);
                u32x2 wv; wv.x = cvt_pk_bf16(o0, o1); wv.y = cvt_pk_bf16(o2, o3);
                *(GAS u32x2*)(umix + (t0 + t) * 2048 + c4) = wv;
            }
        }
        LDS_BARRIER();
    }
}

#define XB_TMO      128
#define XB_XCNT(j)  (256  + 64 * (j))
#define XB_XSUB(j)  (1280 + 64 * (j))
#define XB_XGEN(j)  (2304 + 64 * (j))
#define XB_TOP      3328
#define XB_TOPGEN   3392
#define XCD_BAR_WORDS 3456
#define XB_SPIN_CAP (1u << 18)

__device__ __forceinline__ unsigned xb_ld(unsigned* p)              { return __hip_atomic_load(p, __ATOMIC_RELAXED, __HIP_MEMORY_SCOPE_AGENT); }
__device__ __forceinline__ unsigned xb_add(unsigned* p, unsigned v) { return __hip_atomic_fetch_add(p, v, __ATOMIC_RELAXED, __HIP_MEMORY_SCOPE_AGENT); }
__device__ __forceinline__ unsigned xb_xcc_id() { return (unsigned)__builtin_amdgcn_s_getreg((3 << 11) | 20) & 0xFu; }
#define XB_SPIN(cond, bar) do { unsigned _sp = 0; while (cond) { __builtin_amdgcn_s_sleep(1); \
    if ((++_sp & 255u) == 0u) { if (xb_ld(&(bar)[XB_TMO])) break; if (_sp > XB_SPIN_CAP) { atomicAdd(&(bar)[XB_TMO], 1u); break; } } } } while (0)

struct XcdBarrier {
    unsigned* bar; unsigned x;
    volatile LAS unsigned* st;
};

__device__ __forceinline__ XcdBarrier xcd_barrier_post(unsigned* bar, volatile LAS unsigned* st) {
    XcdBarrier b; b.bar = bar; b.x = xb_xcc_id(); b.st = st;
    if (opq_tid() == 0) (void)xb_add(&bar[XB_XCNT(b.x)], 1u);
    return b;
}
__device__ __forceinline__ void xcd_barrier_complete(unsigned* bar, unsigned x, unsigned& nloc, unsigned& nx) {
    const unsigned G = gridDim.x * gridDim.y * gridDim.z;
    unsigned sum, cnt, mine, sp = 0u;
    for (;;) {
        sum = 0u; cnt = 0u; mine = 0u;
#pragma unroll
        for (unsigned j = 0; j < 16; ++j) { const unsigned c = xb_ld(&bar[XB_XCNT(j)]); sum += c; cnt += (c > 0u) ? 1u : 0u; mine = (j == x) ? c : mine; }
        if (sum == G) break;
        __builtin_amdgcn_s_sleep(1);
        if ((++sp & 255u) == 0u) { if (xb_ld(&bar[XB_TMO])) break; if (sp > XB_SPIN_CAP) { atomicAdd(&bar[XB_TMO], 1u); break; } }
    }
    nloc = mine > 0u ? mine : 1u; nx = cnt > 0u ? cnt : 1u;
}

__device__ __forceinline__ void xcd_barrier(const XcdBarrier& b) {
    asm volatile("s_waitcnt vmcnt(0)" ::: "memory");
    __syncthreads();
    if (opq_tid() == 0) {
        unsigned* bar = b.bar;
        __builtin_amdgcn_s_waitcnt(0);
        unsigned nloc = b.st[0], nx = b.st[1];
        if (nloc == 0u) { xcd_barrier_complete(bar, b.x, nloc, nx); b.st[0] = nloc; b.st[1] = nx; }
        const unsigned old = xb_add(&bar[XB_XSUB(b.x)], 1u);
        const unsigned gen = old / nloc;
        if (old + 1u == (gen + 1u) * nloc) {
            __builtin_amdgcn_fence(__ATOMIC_RELEASE, "agent");
            asm volatile("s_waitcnt vmcnt(0)" ::: "memory");
            const unsigned og = xb_add(&bar[XB_TOP], 1u);
            const unsigned tg = og / nx;
            if (og + 1u == (tg + 1u) * nx) xb_add(&bar[XB_TOPGEN], 1u);
            else XB_SPIN(xb_ld(&bar[XB_TOPGEN]) == tg, bar);
            __builtin_amdgcn_fence(__ATOMIC_ACQUIRE, "agent");
            xb_add(&bar[XB_XGEN(b.x)], 1u);
            asm volatile("s_waitcnt vmcnt(0)" ::: "memory");
        } else {
            XB_SPIN(xb_ld(&bar[XB_XGEN(b.x)]) == gen, bar);
            __builtin_amdgcn_fence(__ATOMIC_ACQUIRE, "agent");
            asm volatile("s_waitcnt vmcnt(0)" ::: "memory");
        }
    }
    __syncthreads();
}


#define WSP(T, off) ((GAS T*)(opq_ptr(P.ws) + (off)))
#define GP(T, p) ((GAS T*)(p))
__global__ void __launch_bounds__(512, 2) mega_fwd(Params P) {
    extern __shared__ __attribute__((aligned(16))) unsigned char lds_raw[];
    LAS unsigned char* lds = (LAS unsigned char*)lds_raw;
    cg::grid_group grid = cg::this_grid();
    { const int t0 = opq_tid();
      if (blockIdx.x == 0) { unsigned* bw = (unsigned*)P.ws; for (int i = t0; i < XCD_BAR_WORDS; i += 512) bw[i] = 0u; }
      if (t0 < 64) ((LAS unsigned*)(lds + 131072))[t0] = 0u; }
    __syncthreads();

    prep_phase(P, lds, opq_s(gridDim.x), opq_s(blockIdx.x));
#pragma unroll 1
    for (int hb = 0; hb < 2; ++hb) {
        int sb = 0, xsel = 0;
        {
            const int G = opq_s(gridDim.x), cb = opq_s(blockIdx.x);
            load_half_phase(GP(const float, P.x) + (size_t)hb * TH * D, WSP(bf16_t, OFF_XB), WSP(float, OFF_SSP0), G, cb);
        }
        __syncthreads();
        if (hb == 0) { __threadfence(); grid.sync(); (void)xcd_barrier_post((unsigned*)P.ws, (volatile LAS unsigned*)(lds + 131072)); }
        else { XcdBarrier bar; bar.bar = (unsigned*)opq_ptr(P.ws); bar.x = xb_xcc_id(); bar.st = (volatile LAS unsigned*)(lds + 131072); xcd_barrier(bar); }
#pragma unroll 1
        for (int step = 0; step < DEPTH * 8; ++step) {
            const int li = step >> 3, ph = step & 7;
            const int kind = li % 3, j = li / 3;
            if ((ph == 2 && kind != 1) || ph == 5) continue;
            const int G = opq_s(gridDim.x), cb = opq_s(blockIdx.x);
            GAS bf16_t* XBc = xsel ? (GAS bf16_t*)opq_ptr(P.out + (size_t)hb * TH * D) : WSP(bf16_t, OFF_XB);
            if (ph == 0) {
                pconv_phase(GP(const float, P.p) + ((size_t)li * TFULL + (size_t)hb * TH) * PLD, WSP(bf16_t, OFF_PB), G, cb);
                const GAS float* ssi = WSP(const float, sb ? OFF_SSP1 : OFF_SSP0);
                if (kind == 0) {
                    pg8::Gemm g{XBc, WSP(const bf16_t, OFF_W) + W_SB_IN + (size_t)j * 3145728, TH, 3072, D}; pg8::StaticOrder S; S.init(TH, 3072, G, cb);
                    EpiBf16Scale E{WSP(bf16_t, OFF_BIG1), 3072, ssi};
                    pg8::gemm_phase(lds, g, S, E);
                } else if (kind == 1) {
                    pg8::Gemm g{XBc, WSP(const bf16_t, OFF_W) + W_RET_IN, TH, 6144, D}; pg8::StaticOrder S; S.init(TH, 6144, G, cb);
                    EpiRetIn E{WSP(bf16_t, OFF_BIG1), ssi, WSP(const float, OFF_COS), WSP(const float, OFF_SIN), WSP(bf16_t, OFF_QF)};
                    pg8::gemm_phase(lds, g, S, E);
                } else {
                    pg8::Gemm g{XBc, WSP(const bf16_t, OFF_W) + W_SGU_IN, TH, 4096, D}; pg8::StaticOrder S; S.init(TH, 4096, G, cb);
                    EpiSguIn E{WSP(bf16_t, OFF_BIG1), ssi, WSP(float, OFF_SSV)};
                    pg8::gemm_phase(lds, g, S, E);
                }
            } else if (ph == 1) {
                if (kind == 0) sb_attn_phase(WSP(const bf16_t, OFF_BIG1), WSP(bf16_t, OFF_BIG2), lds, G, cb);
                else if (kind == 1) ret_core_phase(WSP(const bf16_t, OFF_BIG1), WSP(const bf16_t, OFF_QF), WSP(bf16_t, OFF_BIG2), WSP(float, OFF_RST), lds, G, cb);
                else sgu_core_phase(WSP(const bf16_t, OFF_BIG1), WSP(const float, OFF_SSV), GP(const float, P.sgu_w_s), GP(const float, P.sgu_b_s), GP(const float, P.sgu_norm), WSP(bf16_t, OFF_BIG2), lds, G, cb);
            } else if (ph == 2) {
                ret_norm_phase(WSP(const bf16_t, OFF_BIG1), WSP(bf16_t, OFF_BIG2), WSP(const float, OFF_RST), G, cb);
            } else if (ph == 3) {
                {
                    const GAS bf16_t* Wb = WSP(const bf16_t, OFF_W);
                    const GAS bf16_t* Wo = (kind == 0) ? Wb + W_SB_OUT + (size_t)j * 1048576 : (kind == 1) ? Wb + W_RET_OUT : Wb + W_SGU_OUT;
                    const int Ko = (kind == 0) ? 1024 : 2048;
                    pg8::Gemm g{WSP(const bf16_t, OFF_BIG2), Wo, TH, D, Ko}; pg8::StaticOrder S; S.init(TH, D, G, cb);
                    EpiRes E{XBc, WSP(float, sb ? OFF_SSP0 : OFF_SSP1)};
                    pg8::gemm_phase(lds, g, S, E);
                    sb ^= 1;
                }
            } else if (ph == 4) {
                pg8::Gemm g{XBc, WSP(const bf16_t, OFF_W) + W_FFN_IN + (size_t)li * 5767168, TH, 2 * FFN, D}; pg8::StaticOrder S; S.init(TH, 2 * FFN, G, cb);
                EpiFfnConv E{WSP(bf16_t, OFF_BIG2), WSP(const float, sb ? OFF_SSP1 : OFF_SSP0), GP(const float, P.conv_w) + (size_t)li * 3 * FFN, GP(const float, P.conv_b) + (size_t)li * FFN, WSP(float, OFF_BIG1), WSP(float, OFF_BIG1 + 16 * MiB)};
                pg8::gemm_phase(lds, g, S, E);
                {
                    const int nun = (TH / 256) * (2 * FFN / 256), extra = nun % G;
                    const int Gp = extra ? G - extra : G, cp = extra ? cb - extra : cb;
                    if (cp >= 0) {
                        pg8::Gemm g2{WSP(const bf16_t, OFF_PB), WSP(const bf16_t, OFF_W) + W_PL_PROJ + (size_t)li * 262144, TH, D, PLD}; pg8::StaticOrder S2; S2.init(TH, D, Gp, cp);
                        EpiBf16Scale E2{WSP(bf16_t, OFF_PP), D, nullptr};
                        pg8::gemm_phase(lds, g2, S2, E2);
                    }
                }
            } else if (ph == 6) {
                pg8::Gemm g{WSP(const bf16_t, OFF_BIG2), WSP(const bf16_t, OFF_W) + W_FFN_OUT + (size_t)li * 2883584, TH, D, FFN}; pg8::StaticOrder S; S.init(TH, D, G, cb);
                { pg8::Unit fu; for (int i = 0; S.next(i, fu); ++i) ffn_fixup(WSP(bf16_t, OFF_BIG2), WSP(const float, OFF_BIG1), WSP(const float, OFF_BIG1 + 16 * MiB), GP(const float, P.conv_w) + (size_t)li * 3 * FFN, GP(const float, P.conv_b) + (size_t)li * FFN, fu.pm);
                  asm volatile("s_waitcnt vmcnt(0)" ::: "memory"); __syncthreads(); }
                EpiRes E{XBc, WSP(float, sb ? OFF_SSP0 : OFF_SSP1)};
                pg8::gemm_phase(lds, g, S, E);
                sb ^= 1;
            } else {
                pg8::Gemm g{XBc, WSP(const bf16_t, OFF_W) + W_PL_GATE + (size_t)li * 1048576, TH, D, D}; pg8::StaticOrder S; S.init(TH, D, G, cb);
                GAS bf16_t* XBn = xsel ? WSP(bf16_t, OFF_XB) : (GAS bf16_t*)opq_ptr(P.out + (size_t)hb * TH * D);
                EpiPL E{XBc, XBn, WSP(const float, sb ? OFF_SSP1 : OFF_SSP0), WSP(float, sb ? OFF_SSP0 : OFF_SSP1), WSP(const bf16_t, OFF_PP)};
                pg8::gemm_phase(lds, g, S, E);
                sb ^= 1; xsel ^= 1;
            }
            { XcdBarrier bar; bar.bar = (unsigned*)opq_ptr(P.ws); bar.x = xb_xcc_id(); bar.st = (volatile LAS unsigned*)(lds + 131072); xcd_barrier(bar); }
        }
        final_phase(WSP(const bf16_t, OFF_XB), GP(float, P.out) + (size_t)hb * TH * D, GP(const float, P.norm_final), opq_s(gridDim.x), opq_s(blockIdx.x));
        if (hb == 0) { XcdBarrier bar; bar.bar = (unsigned*)opq_ptr(P.ws); bar.x = xb_xcc_id(); bar.st = (volatile LAS unsigned*)(lds + 131072); xcd_barrier(bar); }
    }
}

extern "C" void kernel_launch(void* const* d_in, const int* in_sizes, int n_in, void* d_out, int out_size, void* d_ws, size_t ws_size, hipStream_t stream) {
    static int grid = 0;
    if (grid == 0) {
        if (n_in != 21 || ws_size < WS_NEED) { fprintf(stderr, "kernel_launch: unexpected n_in %d / ws %zu (need %zu)\n", n_in, ws_size, (size_t)WS_NEED); grid = -1; return; }
        int dev = 0, cus = 0, per_cu = 0;
        hipGetDevice(&dev);
        hipDeviceGetAttribute(&cus, hipDeviceAttributeMultiprocessorCount, dev);
        hipFuncSetAttribute((const void*)mega_fwd, hipFuncAttributeMaxDynamicSharedMemorySize, LDS_BYTES);
        hipOccupancyMaxActiveBlocksPerMultiprocessor(&per_cu, (const void*)mega_fwd, 512, LDS_BYTES);
        if (per_cu < 1) { fprintf(stderr, "kernel_launch: occupancy query says %d blocks/CU\n", per_cu); per_cu = 1; }
        grid = cus * 1;
        if (grid < 192) { fprintf(stderr, "kernel_launch: %d CUs: this build needs >= 192 (8 GEMM units per workgroup per phase at most)\n", grid); grid = -1; return; }
        (void)hipGetLastError();
    }
    if (grid < 0) return;
    Params P{};
    const float* const* in = (const float* const*)d_in;
    P.x = in[0]; P.p = in[1]; P.norm_final = in[5]; P.sgu_norm = in[11]; P.sgu_w_s = in[12]; P.sgu_b_s = in[13];
    P.conv_w = in[16]; P.conv_b = in[17]; P.out = (float*)d_out; P.ws = (unsigned char*)d_ws;
    const float* norm_mix = in[2]; const float* norm_ffn = in[3]; const float* norm_pl = in[4];
    bf16_t* Wb = (bf16_t*)((unsigned char*)d_ws + OFF_W);
    int mi = 0;
    auto add = [&](const float* W, const float* gain, size_t dst, int K, int N, int perm = 0) { P.mats[mi].W = W; P.mats[mi].gain = gain; P.mats[mi].dst = Wb + dst; P.mats[mi].K = K; P.mats[mi].N = N; P.mats[mi].perm = perm; P.mats[mi].pad = 0; ++mi; };
    for (int j = 0; j < 2; ++j) add(in[6] + (size_t)j * 1024 * 3072, norm_mix + (size_t)(3 * j) * 1024, W_SB_IN + (size_t)j * 3145728, 1024, 3072);
    for (int j = 0; j < 2; ++j) add(in[7] + (size_t)j * 1024 * 1024, nullptr, W_SB_OUT + (size_t)j * 1048576, 1024, 1024);
    add(in[8], norm_mix + 1 * 1024, W_RET_IN, 1024, 6144);
    add(in[9], nullptr, W_RET_OUT, 2048, 1024);
    add(in[10], norm_mix + 2 * 1024, W_SGU_IN, 1024, 4096);
    add(in[14], nullptr, W_SGU_OUT, 2048, 1024);
    for (int i = 0; i < 4; ++i) add(in[15] + (size_t)i * 1024 * 5632, norm_ffn + (size_t)i * 1024, W_FFN_IN + (size_t)i * 5767168, 1024, 5632, 1);
    for (int i = 0; i < 4; ++i) add(in[18] + (size_t)i * 2816 * 1024, nullptr, W_FFN_OUT + (size_t)i * 2883584, 2816, 1024);
    for (int i = 0; i < 4; ++i) add(in[19] + (size_t)i * 1024 * 1024, norm_pl + (size_t)i * 1024, W_PL_GATE + (size_t)i * 1048576, 1024, 1024);
    for (int i = 0; i < 4; ++i) add(in[20] + (size_t)i * 256 * 1024, nullptr, W_PL_PROJ + (size_t)i * 262144, 256, 1024);
    void* args[] = {&P};
    hipError_t e = hipLaunchCooperativeKernel((const void*)mega_fwd, dim3(grid), dim3(512), args, LDS_BYTES, stream);
    if (e != hipSuccess) fprintf(stderr, "kernel_launch: cooperative launch failed: %s (grid %d)\n", hipGetErrorString(e), grid);
}
```
